# Optimizing an MI355X kernel written in HIP

```python
import math
import jax
import jax.numpy as jnp
from jax import lax
import numpy as np

D_MODEL = 1024
BATCH = 2
SEQ = 8192
DEPTH = 4

GRID_W = 64
CTX_LEN = 256

SSM_WIDTH = 512
SSM_GROUP = 16
SSM_GROUPS = SSM_WIDTH // SSM_GROUP
SSM_STATE = 64
SSM_DT_MIN = 1e-3
SSM_DT_MAX = 1e-1

NA_HEADS = 8
NA_HEAD_DIM = 64
NA_WIDTH = NA_HEADS * NA_HEAD_DIM
NA_WIN_ROWS = 8
NA_WIN_COLS = 16

MLA_HEADS = 8
MLA_Q_RANK = 256
MLA_KV_RANK = 128
MLA_NOPE_DIM = 64
MLA_ROPE_DIM = 32
MLA_V_DIM = 64
MLA_QK_DIM = MLA_NOPE_DIM + MLA_ROPE_DIM
MLA_WIDTH = MLA_HEADS * MLA_V_DIM

Q_BLOCK = 128
ROPE_THETA = 10000.0
LN_EPS = 1e-5
RMS_EPS = 1e-6
NEG_INF = -1e30
DEEPNORM_ALPHA = (2 * DEPTH) ** 0.25
DEEPNORM_BETA = (8 * DEPTH) ** -0.25
NA_SCALE = NA_HEAD_DIM ** -0.5
MLA_SCALE = MLA_QK_DIM ** -0.5
F32 = jnp.float32

IN_SPLITS = (SSM_WIDTH, SSM_WIDTH,
             NA_WIDTH, NA_WIDTH, NA_WIDTH, NA_WIDTH,
             MLA_Q_RANK, MLA_KV_RANK, MLA_ROPE_DIM, MLA_WIDTH,
             D_MODEL, D_MODEL, D_MODEL)
IN_WIDTH = sum(IN_SPLITS)

kernel_name = 'hybrid_s5_natten_mla_prefix_block'


def layer_norm(x, g=None, b=None):
    xf = x.astype(F32)
    xc = xf - jnp.mean(xf, axis=-1, keepdims=True)
    y = xc * lax.rsqrt(jnp.mean(xc * xc, axis=-1, keepdims=True) + LN_EPS)
    if g is not None:
        y = y * g.astype(F32) + b.astype(F32)
    return y.astype(x.dtype)


def rms_norm(x, g):
    xf = x.astype(F32)
    y = xf * lax.rsqrt(jnp.mean(xf * xf, axis=-1, keepdims=True) + RMS_EPS) * g.astype(F32)
    return y.astype(x.dtype)


def split_cols(p):
    idx = [int(i) for i in np.cumsum(IN_SPLITS)[:-1]]
    return jnp.split(p, idx, axis=-1)


def axial_rope_tables(n_tokens):
    t = jnp.arange(n_tokens, dtype=jnp.int32)
    row = (t // GRID_W).astype(F32)
    col = (t % GRID_W).astype(F32)
    half = MLA_ROPE_DIM // 2
    inv = 1.0 / (ROPE_THETA ** (jnp.arange(0, half, 2, dtype=F32) / half))
    ang_r = row[:, None] * inv[None, :]
    ang_c = col[:, None] * inv[None, :]
    return (jnp.cos(ang_r), jnp.sin(ang_r), jnp.cos(ang_c), jnp.sin(ang_c))


def _rotate(x, cos, sin):
    n = x.shape[-1] // 2
    x1 = x[..., :n].astype(F32)
    x2 = x[..., n:].astype(F32)
    cos = cos[None, :, None, :]
    sin = sin[None, :, None, :]
    return jnp.concatenate([x1 * cos - x2 * sin, x1 * sin + x2 * cos], axis=-1).astype(x.dtype)


def apply_axial_rope(x, rope):
    cos_r, sin_r, cos_c, sin_c = rope
    half = x.shape[-1] // 2
    return jnp.concatenate([_rotate(x[..., :half], cos_r, sin_r),
                            _rotate(x[..., half:], cos_c, sin_c)], axis=-1)


def block_attention(q, k, v, scale):
    B, S, H, dq = q.shape
    nb = S // Q_BLOCK
    qb = jnp.moveaxis(q.reshape(B, nb, Q_BLOCK, H, dq), 1, 0)

    def attend(q_blk):
        s = jnp.einsum('bqhd,bkhd->bhqk', q_blk, k).astype(F32) * scale
        p = jax.nn.softmax(s, axis=-1).astype(v.dtype)
        return jnp.einsum('bhqk,bkhd->bqhd', p, v)

    o = lax.map(attend, qb)
    return jnp.moveaxis(o, 0, 1).reshape(B, S, H * v.shape[-1])


def _complex_combine(e1, e2):
    a1r, a1i, b1r, b1i = e1
    a2r, a2i, b2r, b2i = e2
    return (a2r * a1r - a2i * a1i, a2r * a1i + a2i * a1r,
            a2r * b1r - a2i * b1i + b2r, a2r * b1i + a2i * b1r + b2i)


def s5_discretise(lam_re, lam_im, log_dt, b_re, b_im):
    dt = jnp.exp(log_dt.astype(F32))[:, None]
    lr = lam_re.astype(F32)
    li = lam_im.astype(F32)
    mag = jnp.exp(lr * dt)
    ab_re = mag * jnp.cos(li * dt)
    ab_im = mag * jnp.sin(li * dt)
    nr = ab_re - 1.0
    den = lr * lr + li * li
    fr = (nr * lr + ab_im * li) / den
    fi = (ab_im * lr - nr * li) / den
    br = b_re.astype(F32)
    bi = b_im.astype(F32)
    bb_re = fr[..., None] * br - fi[..., None] * bi
    bb_im = fr[..., None] * bi + fi[..., None] * br
    return ab_re, ab_im, bb_re, bb_im


def s5_states(u, disc, s0):
    ab_re, ab_im, bb_re, bb_im = disc
    bu_re = jnp.einsum('blgi,gpi->blgp', u, bb_re)
    bu_im = jnp.einsum('blgi,gpi->blgp', u, bb_im)
    if s0 is not None:
        s0_re, s0_im = s0
        bu_re = bu_re.at[:, 0].add(ab_re * s0_re - ab_im * s0_im)
        bu_im = bu_im.at[:, 0].add(ab_re * s0_im + ab_im * s0_re)
    a_re = jnp.broadcast_to(ab_re, bu_re.shape)
    a_im = jnp.broadcast_to(ab_im, bu_im.shape)
    _, _, s_re, s_im = lax.associative_scan(_complex_combine, (a_re, a_im, bu_re, bu_im), axis=1)
    return s_re, s_im


def s5_readout(states, c_re, c_im):
    s_re, s_im = states
    return jnp.einsum('gip,blgp->blgi', c_re, s_re) - jnp.einsum('gip,blgp->blgi', c_im, s_im)


def s5_output(y, u, d_skip, w_glu, b_glu):
    B, L, W = u.shape
    y = (y.reshape(B, L, W) + d_skip.astype(F32) * u.astype(F32)).astype(u.dtype)
    y = jax.nn.gelu(y)
    return y * jax.nn.sigmoid(y @ w_glu + b_glu)


def s5_mixer(u_lat, u_ctx, lam_re, lam_im, log_dt, b_re, b_im, c_re, c_im,
             d_skip, w_glu, b_glu, need_ctx):
    B, S, _ = u_lat.shape
    ul = u_lat.astype(F32).reshape(B, S, SSM_GROUPS, SSM_GROUP)
    uc = u_ctx.astype(F32).reshape(B, u_ctx.shape[1], SSM_GROUPS, SSM_GROUP)
    y_lat = 0.0
    y_ctx = 0.0
    for d in range(2):
        disc = s5_discretise(lam_re[d], lam_im[d], log_dt[d], b_re[d], b_im[d])
        cr = c_re[d].astype(F32)
        ci = c_im[d].astype(F32)
        ucd, uld = (uc, ul) if d == 0 else (uc[:, ::-1], ul[:, ::-1])
        sc = s5_states(ucd, disc, None)
        sl = s5_states(uld, disc, (sc[0][:, -1], sc[1][:, -1]))
        yl = s5_readout(sl, cr, ci)
        y_lat = y_lat + (yl if d == 0 else yl[:, ::-1])
        if need_ctx:
            yc = s5_readout(sc, cr, ci)
            y_ctx = y_ctx + (yc if d == 0 else yc[:, ::-1])
    out_lat = s5_output(y_lat, u_lat, d_skip, w_glu, b_glu)
    out_ctx = s5_output(y_ctx, u_ctx, d_skip, w_glu, b_glu) if need_ctx else None
    return out_lat, out_ctx


def neighbourhood_attention(q, k, v, k_ctx, v_ctx, rpb):
    B, S, H, dh = q.shape
    rows = S // GRID_W
    wr = min(NA_WIN_ROWS, rows)
    wc = NA_WIN_COLS
    r = jnp.arange(rows)
    key_rows = jnp.clip(r - wr // 2, 0, rows - wr)[:, None] + jnp.arange(wr)[None, :]
    n_lat = wr * GRID_W
    qr = q.reshape(B, rows, GRID_W, H, dh)
    kg = k.reshape(B, rows, GRID_W, H, dh)[:, key_rows].reshape(B, rows, n_lat, H, dh)
    vg = v.reshape(B, rows, GRID_W, H, dh)[:, key_rows].reshape(B, rows, n_lat, H, dh)
    col = jnp.arange(GRID_W)
    col_start = jnp.clip(col - wc // 2, 0, GRID_W - wc)
    in_win = (col[None, :] >= col_start[:, None]) & (col[None, :] < col_start[:, None] + wc)
    mask = jnp.broadcast_to(in_win[:, None, :], (GRID_W, wr, GRID_W)).reshape(GRID_W, n_lat)
    dr = key_rows - r[:, None]
    dc = col[None, :] - col[:, None]
    idx_r = (dr + NA_WIN_ROWS - 1)[:, None, :, None]
    idx_c = (jnp.clip(dc, -(wc - 1), wc - 1) + NA_WIN_COLS - 1)[None, :, None, :]
    bias = rpb[:, idx_r, idx_c].reshape(H, rows, GRID_W, n_lat).astype(F32)
    s_lat = jnp.einsum('brqhd,brkhd->bhrqk', qr, kg).astype(F32) * NA_SCALE + bias[None]
    s_lat = jnp.where(mask, s_lat, NEG_INF)
    s_ctx = jnp.einsum('brqhd,bkhd->bhrqk', qr, k_ctx).astype(F32) * NA_SCALE
    p = jax.nn.softmax(jnp.concatenate([s_lat, s_ctx], axis=-1), axis=-1).astype(v.dtype)
    o = (jnp.einsum('bhrqk,brkhd->brqhd', p[..., :n_lat], vg)
         + jnp.einsum('bhrqk,bkhd->brqhd', p[..., n_lat:], v_ctx))
    return o.reshape(B, S, H * dh)


def mla_queries(c_q, q_norm, w_uq, rope):
    B, L, _ = c_q.shape
    q = (rms_norm(c_q, q_norm) @ w_uq).reshape(B, L, MLA_HEADS, MLA_QK_DIM)
    q_nope = q[..., :MLA_NOPE_DIM]
    q_pe = q[..., MLA_NOPE_DIM:]
    if rope is not None:
        q_pe = apply_axial_rope(q_pe, rope)
    return jnp.concatenate([q_nope, q_pe], axis=-1)


def mla_keys_values(c_kv, k_rope, kv_norm, w_ukv, rope):
    B, L, _ = c_kv.shape
    kv = (rms_norm(c_kv, kv_norm) @ w_ukv).reshape(B, L, MLA_HEADS, MLA_NOPE_DIM + MLA_V_DIM)
    k_nope = kv[..., :MLA_NOPE_DIM]
    v = kv[..., MLA_NOPE_DIM:]
    k_pe = k_rope[:, :, None, :]
    if rope is not None:
        k_pe = apply_axial_rope(k_pe, rope)
    k = jnp.concatenate([k_nope, jnp.broadcast_to(k_pe, (B, L, MLA_HEADS, MLA_ROPE_DIM))], axis=-1)
    return k, v


def merge_branches(ya, za, yn, zn, ym, zm, ga, gn, gm, w_branch_a, w_branch_b, w_branch_c, w_out):
    silu = jax.nn.silu
    sig = jax.nn.sigmoid
    m = (sig(ga) * ((ya * silu(za)) @ w_branch_a)
         + sig(gn) * ((yn * silu(zn)) @ w_branch_b)
         + sig(gm) * ((ym * silu(zm)) @ w_branch_c))
    return m @ w_out


def na_heads(t):
    return t.reshape(t.shape[0], t.shape[1], NA_HEADS, NA_HEAD_DIM)


def trunk_layer(x, ctx, mod_lat, mod_ctx, w_in, lam_re, lam_im, log_dt, b_re, b_im, c_re, c_im,
                d_skip, w_glu, b_glu, rpb, q_norm, w_uq, kv_norm, w_ukv,
                w_branch_a, w_branch_b, w_branch_c, w_out, ln_g, ln_b, rope, need_ctx):
    shift, scale, gate = jnp.split(mod_lat, 3, axis=-1)
    shift_c, scale_c, gate_c = jnp.split(mod_ctx, 3, axis=-1)
    h = layer_norm(x) * (1.0 + scale[:, None]) + shift[:, None]
    hc = layer_norm(ctx) * (1.0 + scale_c) + shift_c
    (ua, za, qn, kn, vn, zn, cq, ckv, kr, zm, ga, gn, gm) = split_cols(h @ w_in)
    (ua_c, za_c, qn_c, kn_c, vn_c, zn_c, cq_c, ckv_c, kr_c, zm_c, ga_c, gn_c, gm_c) = split_cols(hc @ w_in)

    ya, ya_c = s5_mixer(ua, ua_c, lam_re, lam_im, log_dt, b_re, b_im, c_re, c_im,
                        d_skip, w_glu, b_glu, need_ctx)
    kn_ch = na_heads(kn_c)
    vn_ch = na_heads(vn_c)
    yn = neighbourhood_attention(na_heads(qn), na_heads(kn), na_heads(vn), kn_ch, vn_ch, rpb)
    q_l = mla_queries(cq, q_norm, w_uq, rope)
    k_l, v_l = mla_keys_values(ckv, kr, kv_norm, w_ukv, rope)
    k_c, v_c = mla_keys_values(ckv_c, kr_c, kv_norm, w_ukv, None)
    ym = block_attention(q_l, jnp.concatenate([k_l, k_c], axis=1),
                         jnp.concatenate([v_l, v_c], axis=1), MLA_SCALE)

    out = merge_branches(ya, za, yn, zn, ym, zm, ga, gn, gm, w_branch_a, w_branch_b, w_branch_c, w_out)
    x_new = layer_norm(DEEPNORM_ALPHA * x + gate[:, None] * out, ln_g, ln_b)
    if not need_ctx:
        return x_new, None

    yn_c = block_attention(na_heads(qn_c), kn_ch, vn_ch, NA_SCALE)
    q_c = mla_queries(cq_c, q_norm, w_uq, None)
    ym_c = block_attention(q_c, k_c, v_c, MLA_SCALE)
    out_c = merge_branches(ya_c, za_c, yn_c, zn_c, ym_c, zm_c, ga_c, gn_c, gm_c,
                           w_branch_a, w_branch_b, w_branch_c, w_out)
    ctx_new = layer_norm(DEEPNORM_ALPHA * ctx + gate_c * out_c, ln_g, ln_b)
    return x_new, ctx_new


def setup_inputs(seed: int = 0) -> dict:
    key = jax.random.key(seed)
    ks = jax.random.split(key, 32)
    D = D_MODEL
    G = SSM_GROUPS
    P = SSM_STATE
    Gi = SSM_GROUP

    def nrm(k, shape, s):
        return jax.random.normal(k, shape, F32) * s

    return {
        'x': nrm(ks[0], (BATCH, SEQ, D), 1.0),
        'c': nrm(ks[1], (BATCH, D), 1.0),
        'ctx': nrm(ks[2], (BATCH, CTX_LEN, D), 1.0),
        'c_ctx': nrm(ks[3], (D,), 1.0),
        'w_mod': nrm(ks[4], (DEPTH, D, 3 * D), D ** -0.5),
        'b_mod': nrm(ks[5], (DEPTH, 3 * D), 0.02),
        'w_in': nrm(ks[6], (DEPTH, D, IN_WIDTH), D ** -0.5),
        'ssm_lam_re': -0.5 + nrm(ks[7], (DEPTH, 2, G, P), 0.01),
        'ssm_lam_im': math.pi * jnp.arange(P, dtype=F32) + nrm(ks[8], (DEPTH, 2, G, P), 0.01),
        'ssm_log_dt': jax.random.uniform(ks[9], (DEPTH, 2, G), F32,
                                         math.log(SSM_DT_MIN), math.log(SSM_DT_MAX)),
        'ssm_b_re': nrm(ks[10], (DEPTH, 2, G, P, Gi), (2 * Gi) ** -0.5),
        'ssm_b_im': nrm(ks[11], (DEPTH, 2, G, P, Gi), (2 * Gi) ** -0.5),
        'ssm_c_re': nrm(ks[12], (DEPTH, 2, G, Gi, P), 0.5),
        'ssm_c_im': nrm(ks[13], (DEPTH, 2, G, Gi, P), 0.5),
        'ssm_d': nrm(ks[14], (DEPTH, SSM_WIDTH), 1.0),
        'ssm_w_glu': nrm(ks[15], (DEPTH, SSM_WIDTH, SSM_WIDTH), SSM_WIDTH ** -0.5),
        'ssm_b_glu': nrm(ks[16], (DEPTH, SSM_WIDTH), 0.02),
        'na_rpb': nrm(ks[17], (DEPTH, NA_HEADS, 2 * NA_WIN_ROWS - 1, 2 * NA_WIN_COLS - 1), 0.02),
        'mla_q_norm': 1.0 + nrm(ks[18], (DEPTH, MLA_Q_RANK), 0.02),
        'mla_w_uq': nrm(ks[19], (DEPTH, MLA_Q_RANK, MLA_HEADS * MLA_QK_DIM), MLA_Q_RANK ** -0.5),
        'mla_kv_norm': 1.0 + nrm(ks[20], (DEPTH, MLA_KV_RANK), 0.02),
        'mla_w_ukv': nrm(ks[21], (DEPTH, MLA_KV_RANK, MLA_HEADS * (MLA_NOPE_DIM + MLA_V_DIM)),
                         MLA_KV_RANK ** -0.5),
        'w_branch_a': nrm(ks[22], (DEPTH, SSM_WIDTH, D), SSM_WIDTH ** -0.5),
        'w_branch_b': nrm(ks[23], (DEPTH, NA_WIDTH, D), NA_WIDTH ** -0.5),
        'w_branch_c': nrm(ks[24], (DEPTH, MLA_WIDTH, D), MLA_WIDTH ** -0.5),
        'w_out': nrm(ks[25], (DEPTH, D, D), DEEPNORM_BETA * D ** -0.5),
        'ln_g': 1.0 + nrm(ks[26], (DEPTH, D), 0.02),
        'ln_b': nrm(ks[27], (DEPTH, D), 0.02),
    }


def reference(x, c, ctx, c_ctx, w_mod, b_mod, w_in, ssm_lam_re, ssm_lam_im, ssm_log_dt,
              ssm_b_re, ssm_b_im, ssm_c_re, ssm_c_im, ssm_d, ssm_w_glu, ssm_b_glu, na_rpb,
              mla_q_norm, mla_w_uq, mla_kv_norm, mla_w_ukv, w_branch_a, w_branch_b, w_branch_c,
              w_out, ln_g, ln_b):
    rope = axial_rope_tables(x.shape[1])
    sc = jax.nn.silu(c)
    scc = jax.nn.silu(c_ctx)
    for l in range(DEPTH):
        need_ctx = l < DEPTH - 1
        mod_lat = sc @ w_mod[l] + b_mod[l]
        mod_ctx = scc @ w_mod[l] + b_mod[l]
        x, ctx = trunk_layer(x, ctx, mod_lat, mod_ctx, w_in[l],
                             ssm_lam_re[l], ssm_lam_im[l], ssm_log_dt[l],
                             ssm_b_re[l], ssm_b_im[l], ssm_c_re[l], ssm_c_im[l],
                             ssm_d[l], ssm_w_glu[l], ssm_b_glu[l], na_rpb[l],
                             mla_q_norm[l], mla_w_uq[l], mla_kv_norm[l], mla_w_ukv[l],
                             w_branch_a[l], w_branch_b[l], w_branch_c[l], w_out[l],
                             ln_g[l], ln_b[l], rope, need_ctx)
    return x
```

```cpp
#include <hip/hip_runtime.h>
#include <hip/hip_cooperative_groups.h>
#include <cstdio>
#include <cstdint>
namespace cg = cooperative_groups;
#ifndef EN_NA
#define EN_NA 1
#endif
#ifndef EN_MLA
#define EN_MLA 1
#endif
#ifndef EN_CTXU
#define EN_CTXU 1
#endif
#ifndef EN_S5C
#define EN_S5C 1
#endif

typedef unsigned short bf16_t;
typedef short bf16x8 __attribute__((ext_vector_type(8)));
typedef float f32x16 __attribute__((ext_vector_type(16)));
typedef float f32x4 __attribute__((ext_vector_type(4)));
typedef unsigned u32x4 __attribute__((ext_vector_type(4)));
typedef unsigned u32x2 __attribute__((ext_vector_type(2)));

constexpr int DM = 1024, SEQ = 8192, CTX = 256, TB = SEQ + CTX, NTOK = 2 * TB, DEPTH = 4;
constexpr int NP = 7168;
constexpr int C_UA = 0, C_ZA = 512, C_QN = 1024, C_KN = 1536, C_VN = 2048, C_ZN = 2560, C_CQ = 3072, C_CKV = 3328, C_KR = 3456, C_ZM = 3584, C_GA = 4096;
constexpr int NCH = 132;
constexpr float LOG2E = 1.4426950408889634f;
constexpr float NA_QS = 0.125f * LOG2E;
constexpr float MLA_QS = 0.10206207261596577f * LOG2E;
constexpr float ATT_THR = 8.0f;
constexpr float DN_ALPHA = 1.6817928305074290f;

constexpr size_t MiB = 1u << 20;
constexpr size_t WS_MOD = 0;
constexpr size_t WS_ROPE = 256 * 1024;
constexpr size_t WS_SA = 512 * 1024;
constexpr size_t WS_BBT = 1 * MiB;
constexpr size_t WS_CCT = 2 * MiB;
constexpr size_t WS_BAR = 768 * 1024;
constexpr size_t WS_WIN = 4 * MiB;
constexpr size_t WS_WUQ = 18 * MiB;
constexpr size_t WS_WUKV = WS_WUQ + 512 * 1024;
constexpr size_t WS_WGLU = 19 * MiB;
constexpr size_t WS_WBR = 20 * MiB;
constexpr size_t WS_WOUT = 23 * MiB;
constexpr size_t WS_X = 25 * MiB;
constexpr size_t WS_H = 91 * MiB;
constexpr size_t WS_P = 124 * MiB;
constexpr size_t WS_K = 355 * MiB;
constexpr size_t WS_VMT = 380 * MiB;
constexpr size_t WS_VNT = 397 * MiB;
constexpr size_t WS_E = 414 * MiB;
constexpr size_t WS_XP = 423 * MiB;
constexpr size_t WS_END = 431 * MiB;

constexpr int LDS_STAGE = 135168;
constexpr int LDS_RSTD = LDS_STAGE;
constexpr int LDS_RPB = LDS_STAGE + 1024;
constexpr int LDS_BYTES = 155648;
constexpr int LDS_XB = LDS_BYTES - 16;

struct Params {
  const float* in[28];
  float* out;
  unsigned char* ws;
};

__device__ __forceinline__ float bf2f(unsigned short b) { return __uint_as_float(((unsigned)b) << 16); }
__device__ __forceinline__ unsigned f2bf(float f) { unsigned u = __float_as_uint(f); u += 0x7fffu + ((u >> 16) & 1u); return u >> 16; }
typedef float f32x2_t __attribute__((ext_vector_type(2))); typedef __bf16 bf16x2_t __attribute__((ext_vector_type(2)));
__device__ __forceinline__ unsigned pk2(float lo, float hi) { f32x2_t v = {lo, hi}; bf16x2_t b = __builtin_convertvector(v, bf16x2_t); return __builtin_bit_cast(unsigned, b); }
__device__ __forceinline__ void unpack8(const u32x4 w, float* f) {
#pragma unroll
  for (int i = 0; i < 4; ++i) { f[2 * i] = __uint_as_float(w[i] << 16); f[2 * i + 1] = __uint_as_float(w[i] & 0xffff0000u); }
}
__device__ __forceinline__ u32x4 pack8(const float* f) { u32x4 w; w[0] = pk2(f[0], f[1]); w[1] = pk2(f[2], f[3]); w[2] = pk2(f[4], f[5]); w[3] = pk2(f[6], f[7]); return w; }
__device__ __forceinline__ float sigmoidf_(float x) { return __builtin_amdgcn_rcpf(1.0f + __expf(-x)); }
__device__ __forceinline__ float siluf_(float x) { return x * __builtin_amdgcn_rcpf(1.0f + __expf(-x)); }
__device__ __forceinline__ float geluf_(float x) { const float u = 0.7978845608028654f * (x + 0.044715f * x * x * x); return x * __builtin_amdgcn_rcpf(1.0f + __expf(-2.0f * u)); }
__device__ __forceinline__ int crow(int r, int hi) { return (r & 3) + 8 * (r >> 2) + 4 * hi; }
__device__ __forceinline__ float xhalf(float v) { return __shfl_xor(v, 32); }
__device__ __forceinline__ float xhalf_max(float v) { auto rr = __builtin_amdgcn_permlane32_swap(__float_as_uint(v), __float_as_uint(v), false, false); return fmaxf(__uint_as_float(rr[0]), __uint_as_float(rr[1])); }
__device__ __forceinline__ bf16x8 as_bf16x8(u32x4 w) { return __builtin_bit_cast(bf16x8, w); }
__device__ __forceinline__ int otid() { int t = threadIdx.x; asm volatile("" : "+v"(t)); return t; }
__device__ __forceinline__ unsigned char* opq(unsigned char* x) { asm volatile("" : "+s"(x)); return x; }
#define MFMA32(a, b, c) __builtin_amdgcn_mfma_f32_32x32x16_bf16((a), (b), (c), 0, 0, 0)
#define WAVE_LDS_FENCE() asm volatile("s_waitcnt lgkmcnt(0)" ::: "memory")

__device__ __forceinline__ void gemm_mainloop(char* lds, const bf16_t* A, int lda, const bf16_t* Bt, int ldb, int K, f32x16 (&acc)[2][2]) {
  const int tid = otid(), lane = tid & 63, wid = tid >> 6, wm = wid >> 1, wn = wid & 1, l31 = lane & 31, hh = lane >> 5;
  const int lr = tid >> 3, lc = tid & 7;
  const bf16_t* ga = A + (size_t)lr * lda + lc * 8;
  const bf16_t* gb = Bt + (size_t)lr * ldb + lc * 8;
  u32x4 ra0, ra1, ra2, ra3, rb0, rb1;
  ra0 = *(const u32x4*)(ga); ra1 = *(const u32x4*)(ga + (size_t)64 * lda); ra2 = *(const u32x4*)(ga + (size_t)128 * lda); ra3 = *(const u32x4*)(ga + (size_t)192 * lda);
  rb0 = *(const u32x4*)(gb); rb1 = *(const u32x4*)(gb + (size_t)64 * ldb);
  const int woff = lr * 144 + lc * 16;
  {
    char* As = lds; char* Bs = lds + 36864;
    *(u32x4*)(As + woff) = ra0; *(u32x4*)(As + woff + 64 * 144) = ra1; *(u32x4*)(As + woff + 128 * 144) = ra2; *(u32x4*)(As + woff + 192 * 144) = ra3;
    *(u32x4*)(Bs + woff) = rb0; *(u32x4*)(Bs + woff + 64 * 144) = rb1;
  }
  __syncthreads();
  const int nk = K >> 6;
  const int aoff = (wm * 64 + l31) * 144 + hh * 16, boff = (wn * 64 + l31) * 144 + hh * 16;
  for (int kt = 0; kt < nk; ++kt) {
    const int st = kt & 1;
    const bool more = (kt + 1 < nk);
    if (more) {
      const int k0 = (kt + 1) * 64;
      ra0 = *(const u32x4*)(ga + k0); ra1 = *(const u32x4*)(ga + (size_t)64 * lda + k0); ra2 = *(const u32x4*)(ga + (size_t)128 * lda + k0); ra3 = *(const u32x4*)(ga + (size_t)192 * lda + k0);
      rb0 = *(const u32x4*)(gb + k0); rb1 = *(const u32x4*)(gb + (size_t)64 * ldb + k0);
    }
    const char* As = lds + st * 55296; const char* Bs = As + 36864;
#pragma unroll
    for (int ks = 0; ks < 4; ++ks) {
      const bf16x8 a0 = *(const bf16x8*)(As + aoff + ks * 32), a1 = *(const bf16x8*)(As + aoff + 32 * 144 + ks * 32);
      const bf16x8 b0 = *(const bf16x8*)(Bs + boff + ks * 32), b1 = *(const bf16x8*)(Bs + boff + 32 * 144 + ks * 32);
      acc[0][0] = MFMA32(a0, b0, acc[0][0]); acc[0][1] = MFMA32(a0, b1, acc[0][1]);
      acc[1][0] = MFMA32(a1, b0, acc[1][0]); acc[1][1] = MFMA32(a1, b1, acc[1][1]);
    }
    if (more) {
      char* Aw = lds + (st ^ 1) * 55296; char* Bw = Aw + 36864;
      *(u32x4*)(Aw + woff) = ra0; *(u32x4*)(Aw + woff + 64 * 144) = ra1; *(u32x4*)(Aw + woff + 128 * 144) = ra2; *(u32x4*)(Aw + woff + 192 * 144) = ra3;
      *(u32x4*)(Bw + woff) = rb0; *(u32x4*)(Bw + woff + 64 * 144) = rb1;
    }
    __syncthreads();
  }
}
__device__ __forceinline__ void zero_acc(f32x16 (&acc)[2][2]) {
#pragma unroll
  for (int a = 0; a < 2; ++a)
#pragma unroll
    for (int b = 0; b < 2; ++b)
#pragma unroll
      for (int r = 0; r < 16; ++r) acc[a][b][r] = 0.f;
}
__device__ __forceinline__ void stage_acc(char* lds, const f32x16 (&acc)[2][2]) {
  const int tid = otid(), lane = tid & 63, wid = tid >> 6, wm = wid >> 1, wn = wid & 1, l31 = lane & 31, hh = lane >> 5;
  float* st = (float*)lds;
#pragma unroll
  for (int mi = 0; mi < 2; ++mi)
#pragma unroll
    for (int ni = 0; ni < 2; ++ni)
#pragma unroll
      for (int r = 0; r < 16; ++r) st[(wm * 64 + mi * 32 + crow(r, hh)) * 132 + wn * 64 + ni * 32 + l31] = acc[mi][ni][r];
  __syncthreads();
}
__device__ __forceinline__ void read_chunk(const char* lds, int i, int& row, int& col, float* v) {
  const int id = otid() + 512 * i; row = id >> 4; col = (id & 15) * 8;
  const float* st = (const float*)lds + row * 132 + col;
  const f32x4 x = *(const f32x4*)st, y = *(const f32x4*)(st + 4);
  v[0] = x[0]; v[1] = x[1]; v[2] = x[2]; v[3] = x[3]; v[4] = y[0]; v[5] = y[1]; v[6] = y[2]; v[7] = y[3];
}

__device__ __forceinline__ void wave_ln(f32x4 (&v)[4]) {
  float s = 0.f;
#pragma unroll
  for (int i = 0; i < 4; ++i) s += (v[i][0] + v[i][1]) + (v[i][2] + v[i][3]);
#pragma unroll
  for (int o = 32; o >= 1; o >>= 1) s += __shfl_xor(s, o);
  const float mean = s * (1.0f / 1024.0f);
  float q = 0.f;
#pragma unroll
  for (int i = 0; i < 4; ++i) { v[i] = v[i] - mean; q += (v[i][0] * v[i][0] + v[i][1] * v[i][1]) + (v[i][2] * v[i][2] + v[i][3] * v[i][3]); }
#pragma unroll
  for (int o = 32; o >= 1; o >>= 1) q += __shfl_xor(q, o);
  const float rstd = 1.0f / sqrtf(q * (1.0f / 1024.0f) + 1e-5f);
#pragma unroll
  for (int i = 0; i < 4; ++i) v[i] = v[i] * rstd;
}

__device__ __forceinline__ void convT(const float* __restrict__ src, int ldsrc, int K, int n0, int ncnt, bf16_t* __restrict__ dst, const float* __restrict__ kscale, int gtid, int gthreads) {
  const int total = ncnt * (K >> 3);
  int idx = gtid;
  for (; idx + gthreads < total; idx += 2 * gthreads) {
    const int i1 = idx + gthreads;
    const int na = idx % ncnt, ka = idx / ncnt, nb = i1 % ncnt, kb = i1 / ncnt;
    float fa[8], fb[8];
#pragma unroll
    for (int j = 0; j < 8; ++j) { fa[j] = src[(size_t)(ka * 8 + j) * ldsrc + n0 + na]; fb[j] = src[(size_t)(kb * 8 + j) * ldsrc + n0 + nb]; }
    if (kscale) {
#pragma unroll
      for (int j = 0; j < 8; ++j) { fa[j] *= kscale[ka * 8 + j]; fb[j] *= kscale[kb * 8 + j]; }
    }
    *(u32x4*)(dst + (size_t)na * K + ka * 8) = pack8(fa);
    *(u32x4*)(dst + (size_t)nb * K + kb * 8) = pack8(fb);
  }
  if (idx < total) {
    const int n = idx % ncnt, k8 = idx / ncnt;
    float f[8];
#pragma unroll
    for (int j = 0; j < 8; ++j) { f[j] = src[(size_t)(k8 * 8 + j) * ldsrc + n0 + n]; if (kscale) f[j] *= kscale[k8 * 8 + j]; }
    *(u32x4*)(dst + (size_t)n * K + k8 * 8) = pack8(f);
  }
}
__device__ void convert_layer_weights(const Params& p, int l, int gtid, int gthreads, int part) {
  unsigned char* ws = opq(p.ws);
  if (part != 1) {
    bf16_t* win = (bf16_t*)(ws + WS_WIN);
    const float* w_in = p.in[6] + (size_t)l * 1024 * 7072;
    convT(w_in, 7072, 1024, 0, 3488, win, nullptr, gtid, gthreads);
    for (int idx = gtid; idx < 96 * 128; idx += gthreads) { unsigned z0 = 0u; asm volatile("" : "+v"(z0)); *(u32x4*)(win + (size_t)3488 * 1024 + (size_t)idx * 8) = (u32x4){z0, z0, z0, z0}; }
    convT(w_in, 7072, 1024, 3488, 3584, win + (size_t)3584 * 1024, nullptr, gtid, gthreads);
    convT(p.in[19] + (size_t)l * 256 * 768, 768, 256, 0, 768, (bf16_t*)(ws + WS_WUQ), p.in[18] + l * 256, gtid, gthreads);
    convT(p.in[21] + (size_t)l * 128 * 1024, 1024, 128, 0, 1024, (bf16_t*)(ws + WS_WUKV), p.in[20] + l * 128, gtid, gthreads);
  }
  if (part != 0) {
    convT(p.in[15] + (size_t)l * 512 * 512, 512, 512, 0, 512, (bf16_t*)(ws + WS_WGLU), nullptr, gtid, gthreads);
    convT(p.in[22] + (size_t)l * 512 * 1024, 1024, 512, 0, 1024, (bf16_t*)(ws + WS_WBR), nullptr, gtid, gthreads);
    convT(p.in[23] + (size_t)l * 512 * 1024, 1024, 512, 0, 1024, (bf16_t*)(ws + WS_WBR) + (size_t)1024 * 512, nullptr, gtid, gthreads);
    convT(p.in[24] + (size_t)l * 512 * 1024, 1024, 512, 0, 1024, (bf16_t*)(ws + WS_WBR) + (size_t)2048 * 512, nullptr, gtid, gthreads);
    convT(p.in[25] + (size_t)l * 1024 * 1024, 1024, 1024, 0, 1024, (bf16_t*)(ws + WS_WOUT), nullptr, gtid, gthreads);
  }
}

constexpr int S5_WLDS = 18944;
__device__ void s5_item(const Params& p, int l, int b, int g, int m, int mode, char* wlds, int wofs = 0) {
  const int lane = otid() & 63, l31 = lane & 31, hh = lane >> 5;
  unsigned char* ws = opq(p.ws);
  bf16_t* P = (bf16_t*)(ws + WS_P);
  float* E = (float*)(ws + WS_E);
  char* BUT = wlds; char* ST = wlds + 10240;
  const int t0 = (m < 128) ? 64 * m : 8192 + 64 * (m - 128);
  bf16_t* U = P + (size_t)(b * TB + t0) * NP + C_UA + g * 16;
  f32x16 accY0, accY1;
#pragma unroll
  for (int r = 0; r < 16; ++r) { accY0[r] = 0.f; accY1[r] = 0.f; }
  const bf16x8 uf0 = as_bf16x8(*(const u32x4*)(U + (size_t)l31 * NP + 8 * hh));
  const bf16x8 uf1 = as_bf16x8(*(const u32x4*)(U + (size_t)(32 + l31) * NP + 8 * hh));
#pragma unroll 1
  for (int d = 0; d < 2; ++d) {
    const int cd = (m < 128) ? (d == 0 ? 4 + m : 4 + 127 - m) : (d == 0 ? (m - 128) : 3 - (m - 128));
    const int dg = ((l * 2 + d) * 32 + g);
    const f32x4 av = *(const f32x4*)((const float*)(ws + WS_SA) + ((size_t)dg * 64 + lane) * 4);
    const bf16_t* bbt = (const bf16_t*)(ws + WS_BBT) + (size_t)dg * 128 * 16 + (size_t)l31 * 16 + 8 * hh;
    const bf16_t* cct = (const bf16_t*)(ws + WS_CCT) + (size_t)dg * 32 * 128 + (size_t)l31 * 128 + 8 * hh;
    float* Ed = E + ((size_t)((d * 2 + b) * 32 + g) * NCH) * 128 + lane;
    bf16x8 bbf[4], ccf[8];
#pragma unroll
    for (int ni = 0; ni < 4; ++ni) bbf[ni] = as_bf16x8(*(const u32x4*)(bbt + (size_t)(32 * ni) * 16));
    if (mode == 1) {
#pragma unroll
      for (int ks = 0; ks < 8; ++ks) ccf[ks] = as_bf16x8(*(const u32x4*)(cct + 16 * ks));
    }
    float sr = 0.f, si = 0.f;
    if (mode == 1) { sr = Ed[(size_t)cd * 128]; si = Ed[(size_t)cd * 128 + 64]; }
#pragma unroll 1
    for (int ss = 0; ss < 2; ++ss) {
      const int sub = (d == 0) ? ss : 1 - ss;
      const bf16x8 uf = sub ? uf1 : uf0;
#pragma unroll
      for (int ni = 0; ni < 4; ++ni) {
        f32x16 z;
#pragma unroll
        for (int r = 0; r < 16; ++r) z[r] = 0.f;
        z = MFMA32(uf, bbf[ni], z);
        char* wp = BUT + (32 * ni + l31) * 80 + 8 * hh;
#pragma unroll
        for (int rg = 0; rg < 4; ++rg) { u32x2 w; w[0] = pk2(z[4 * rg], z[4 * rg + 1]); w[1] = pk2(z[4 * rg + 2], z[4 * rg + 3]); *(u32x2*)(wp + 16 * rg) = w; }
      }
      WAVE_LDS_FENCE();
#pragma unroll
      for (int hf = 0; hf < 2; ++hf) {
        const int base = (d == 0) ? 16 * hf : 16 * (1 - hf);
        const u32x4 ra = *(const u32x4*)(BUT + lane * 80 + base * 2), rb = *(const u32x4*)(BUT + lane * 80 + base * 2 + 16);
        const u32x4 ia = *(const u32x4*)(BUT + (64 + lane) * 80 + base * 2), ib = *(const u32x4*)(BUT + (64 + lane) * 80 + base * 2 + 16);
        float br[16], bi[16];
        unpack8(ra, br); unpack8(rb, br + 8); unpack8(ia, bi); unpack8(ib, bi + 8);
        if (d == 0) {
#pragma unroll
          for (int jj = 0; jj < 16; ++jj) { const float nr = av[0] * sr - av[1] * si + br[jj], ni = av[0] * si + av[1] * sr + bi[jj]; sr = nr; si = ni; br[jj] = nr; bi[jj] = ni; }
        } else {
#pragma unroll
          for (int jj = 15; jj >= 0; --jj) { const float nr = av[0] * sr - av[1] * si + br[jj], ni = av[0] * si + av[1] * sr + bi[jj]; sr = nr; si = ni; br[jj] = nr; bi[jj] = ni; }
        }
        if (mode == 1) {
#pragma unroll
          for (int jj = 0; jj < 16; ++jj) *(unsigned*)(ST + (base + jj) * 272 + lane * 4) = pk2(br[jj], bi[jj]);
        }
      }
      WAVE_LDS_FENCE();
      if (mode == 1) {
        f32x16 ay = sub ? accY1 : accY0;
#pragma unroll
        for (int ks = 0; ks < 8; ++ks) {
          const bf16x8 sf = *(const bf16x8*)(ST + l31 * 272 + (16 * ks + 8 * hh) * 2);
          ay = MFMA32(sf, ccf[ks], ay);
        }
        if (sub) accY1 = ay; else accY0 = ay;
        WAVE_LDS_FENCE();
      }
    }
    if (mode == 0) { Ed[(size_t)cd * 128] = sr; Ed[(size_t)cd * 128 + 64] = si; }
  }
  if (mode == 1 && l31 < 16) {
    const float dsk = p.in[14][l * 512 + g * 16 + l31];
    bf16_t* ub = U + (size_t)(4 * hh) * NP + l31;
    float uv[32];
#pragma unroll
    for (int r = 0; r < 16; ++r) { uv[r] = bf2f(ub[(size_t)((r & 3) + 8 * (r >> 2)) * NP]); uv[16 + r] = bf2f(ub[(size_t)(32 + (r & 3) + 8 * (r >> 2)) * NP]); }
#pragma unroll
    for (int r = 0; r < 16; ++r) {
      const float y0 = accY0[r] + dsk * uv[r], y1 = accY1[r] + dsk * uv[16 + r];
      ub[(size_t)((r & 3) + 8 * (r >> 2)) * NP + wofs] = (bf16_t)f2bf(geluf_(y0));
      ub[(size_t)(32 + (r & 3) + 8 * (r >> 2)) * NP + wofs] = (bf16_t)f2bf(geluf_(y1));
    }
  }
}

template <int DQK, bool NA>
__device__ void attn_unit(char* lds, const bf16_t* Qw, int ldq, const bf16_t* Kb, int ldk, const bf16_t* Vt,
                          int ntile, int nwin, int klo, int qrow, int qc0, bf16_t* Ow) {
  constexpr int NKS = DQK / 16, KCH = DQK / 8;
  const int tid = otid(), lane = tid & 63, l31 = lane & 31, hh = lane >> 5;
  const float* rpbs = (const float*)(lds + LDS_RPB);
  bf16x8 qf[NKS];
#pragma unroll
  for (int ks = 0; ks < NKS; ++ks) qf[ks] = as_bf16x8(*(const u32x4*)(Qw + (size_t)l31 * ldq + ks * 16 + hh * 8));
  f32x16 o0, o1;
#pragma unroll
  for (int r = 0; r < 16; ++r) { o0[r] = 0.f; o1[r] = 0.f; }
  float mrun = 0.f, lsum = 0.f; bool first = true;
  f32x16 negm;
#pragma unroll
  for (int r = 0; r < 16; ++r) negm[r] = 0.f;
  const int vdv = tid >> 3, vch = tid & 7;
  int kr0, kc0, kr1 = 0, kc1 = 0; bool k1on = false;
  if (KCH == 8) { kr0 = tid >> 3; kc0 = tid & 7; }
  else { kr0 = tid / 12; kc0 = tid % 12; const int id1 = tid + 512; k1on = id1 < 768; kr1 = id1 / 12; kc1 = id1 % 12; }
  u32x4 rk0, rk1 = (u32x4){0u, 0u, 0u, 0u}, rv;
  auto tile_t0 = [&](int i) -> int { return (i < nwin) ? (klo + i) * 64 : 8192 + (i - nwin) * 64; };
  auto gload = [&](int i) {
    const int t0 = tile_t0(i);
    rk0 = *(const u32x4*)(Kb + (size_t)(t0 + kr0) * ldk + kc0 * 8);
    if (KCH != 8 && k1on) rk1 = *(const u32x4*)(Kb + (size_t)(t0 + kr1) * ldk + kc1 * 8);
    rv = *(const u32x4*)(Vt + (size_t)vdv * TB + t0 + vch * 8);
  };
  auto swrite = [&](int st) {
    char* Ks = lds + st * 13312; char* Vs = lds + 26624 + st * 9216;
    *(u32x4*)(Ks + kr0 * 208 + kc0 * 16) = rk0;
    if (KCH != 8 && k1on) *(u32x4*)(Ks + kr1 * 208 + kc1 * 16) = rk1;
    { char* vr = Vs + vdv * 144 + (vch >> 1) * 32 + (vch & 1) * 8; *(u32x2*)(vr) = (u32x2){rv[0], rv[1]}; *(u32x2*)(vr + 16) = (u32x2){rv[2], rv[3]}; }
  };
  gload(0); swrite(0);
  __syncthreads();
  const int krs = NA ? min(max(qrow - 4, 0), 120) : 0;
  const int qc = qc0 + l31;
  const int cs = NA ? min(max(qc - 8, 0), 48) : 0;
  for (int i = 0; i < ntile; ++i) {
    const int st = i & 1;
    const bool more = (i + 1 < ntile);
    if (more) gload(i + 1);
    bool active = true; bool win = false; int kr = 0;
    if (NA && i < nwin) { kr = klo + i; win = true; active = (kr >= krs) && (kr < krs + 8); }
    if (active) {
      const char* Ks = lds + st * 13312; const char* Vs = lds + 26624 + st * 9216;
      f32x16 s0, s1;
      bf16x8 kf[2 * NKS];
#pragma unroll
      for (int ks = 0; ks < NKS; ++ks) { kf[2 * ks] = *(const bf16x8*)(Ks + l31 * 208 + ks * 32 + hh * 16); kf[2 * ks + 1] = *(const bf16x8*)(Ks + (32 + l31) * 208 + ks * 32 + hh * 16); }
      __builtin_amdgcn_sched_barrier(0);
#pragma unroll
      for (int ks = 0; ks < NKS; ++ks) {
        if (ks == 0) { s0 = MFMA32(kf[0], qf[0], negm); s1 = MFMA32(kf[1], qf[0], negm); }
        else { s0 = MFMA32(kf[2 * ks], qf[ks], s0); s1 = MFMA32(kf[2 * ks + 1], qf[ks], s1); }
      }
      bf16x8 vf0[4], vf1[4];
#pragma unroll
      for (int s4 = 0; s4 < 4; ++s4) { vf0[s4] = *(const bf16x8*)(Vs + l31 * 144 + s4 * 32 + hh * 16); vf1[s4] = *(const bf16x8*)(Vs + (32 + l31) * 144 + s4 * 32 + hh * 16); }
      __builtin_amdgcn_sched_barrier(0);
      if (NA && win) {
        const float* rpl = rpbs + (kr - qrow + 7) * 31 + (4 * hh - qc + 15);
        const int kb = 4 * hh - cs;
#pragma unroll
        for (int r = 0; r < 16; ++r) {
          const int c0 = (r & 3) + 8 * (r >> 2);
          s0[r] = ((unsigned)(kb + c0) < 16u) ? s0[r] + rpl[c0] : -INFINITY;
          s1[r] = ((unsigned)(kb + c0 + 32) < 16u) ? s1[r] + rpl[c0 + 32] : -INFINITY;
        }
      }
      float ma = fmaxf(fmaxf(s0[0], s0[1]), s1[0]), mb = fmaxf(fmaxf(s0[2], s0[3]), s1[1]);
      ma = fmaxf(fmaxf(ma, s1[2]), s1[3]);
#pragma unroll
      for (int r = 4; r < 16; r += 4) { ma = fmaxf(fmaxf(ma, s0[r]), s0[r + 1]); mb = fmaxf(fmaxf(mb, s0[r + 2]), s0[r + 3]); ma = fmaxf(fmaxf(ma, s1[r]), s1[r + 1]); mb = fmaxf(fmaxf(mb, s1[r + 2]), s1[r + 3]); }
      float mx = fmaxf(ma, mb);
      mx = xhalf_max(mx);
      if (first || __any(mx > ATT_THR)) {
        const float dl = first ? mx : fmaxf(mx, 0.f);
        const float al = first ? 1.0f : __builtin_amdgcn_exp2f(-dl);
        first = false;
        mrun += dl;
        lsum *= al;
#pragma unroll
        for (int r = 0; r < 16; ++r) { s0[r] -= dl; s1[r] -= dl; o0[r] *= al; o1[r] *= al; negm[r] = -mrun; }
      }
      f32x2_t ps2 = {0.f, 0.f};
#pragma unroll
      for (int r = 0; r < 16; ++r) { s0[r] = __builtin_amdgcn_exp2f(s0[r]); s1[r] = __builtin_amdgcn_exp2f(s1[r]); }
#pragma unroll
      for (int r = 0; r < 16; r += 2) { ps2 += (f32x2_t){s0[r], s0[r + 1]}; ps2 += (f32x2_t){s1[r], s1[r + 1]}; }
      lsum += ps2[0] + ps2[1];
      u32x4 pw[4];
#pragma unroll
      for (int j = 0; j < 4; ++j) { pw[0][j] = pk2(s0[2 * j], s0[2 * j + 1]); pw[1][j] = pk2(s0[8 + 2 * j], s0[8 + 2 * j + 1]); pw[2][j] = pk2(s1[2 * j], s1[2 * j + 1]); pw[3][j] = pk2(s1[8 + 2 * j], s1[8 + 2 * j + 1]); }
#pragma unroll
      for (int s4 = 0; s4 < 4; ++s4) {
        o0 = MFMA32(vf0[s4], as_bf16x8(pw[s4]), o0);
        o1 = MFMA32(vf1[s4], as_bf16x8(pw[s4]), o1);
      }
    }
    if (more) swrite(st ^ 1);
    __syncthreads();
  }
  const float lt = lsum + xhalf(lsum);
  const float inv = 1.0f / lt;
  bf16_t* orow = Ow + (size_t)l31 * NP;
  u32x2 zall[8];
#pragma unroll
  for (int q8 = 0; q8 < 8; ++q8) zall[q8] = *(const u32x2*)(orow + (q8 >> 2) * 32 + 8 * (q8 & 3) + 4 * hh);
#pragma unroll
  for (int dvb = 0; dvb < 2; ++dvb)
#pragma unroll
    for (int rg = 0; rg < 4; ++rg) {
      const int dv = dvb * 32 + 8 * rg + 4 * hh;
      const u32x2 zw = zall[dvb * 4 + rg];
      float z[4] = {__uint_as_float(zw[0] << 16), __uint_as_float(zw[0] & 0xffff0000u), __uint_as_float(zw[1] << 16), __uint_as_float(zw[1] & 0xffff0000u)};
      float ov[4];
#pragma unroll
      for (int j = 0; j < 4; ++j) { const float oo = (dvb == 0 ? o0[4 * rg + j] : o1[4 * rg + j]) * inv; ov[j] = oo * siluf_(z[j]); }
      u32x2 w; w[0] = pk2(ov[0], ov[1]); w[1] = pk2(ov[2], ov[3]);
      *(u32x2*)(orow + dv) = w;
    }
}


namespace pg8 {
#define PG8_LAS __attribute__((address_space(3)))
typedef unsigned short bf16_t;
typedef short bf16x8 __attribute__((ext_vector_type(8)));
typedef float f32x4 __attribute__((ext_vector_type(4)));
typedef unsigned u32x4 __attribute__((ext_vector_type(4)));
constexpr int BM = 256, BK = 64, HALF = 128, HTB = HALF * BK * 2  , STAGE_BYTES = 8 * HTB, NXCD = 8, WGM = 8;

__host__ __device__ __forceinline__ int lds_byte(int r, int c) { const int st = (r >> 4) * 2 + (c >> 5), rr = r & 15, cc = c & 31, ob = rr * 64 + cc * 2; return st * 1024 + (ob ^ (((ob >> 9) & 1) << 5)); }
__host__ __device__ __forceinline__ void stage_rc(int b, int& R, int& C) { const int st = b / 1024, sb = b % 1024, swz = sb ^ (((sb >> 9) & 1) << 5); R = (st >> 1) * 16 + swz / 64; C = (st & 1) * 32 + (swz % 64) / 2; }
__host__ __device__ __forceinline__ int perm32(int rho) { const int n = rho >> 4, i = rho & 15; return 8 * (i >> 2) + 4 * n + (i & 3); }

struct Unit { int pm, pn; };
struct Gemm { const bf16_t* A; const bf16_t* Bt; int M, N, K, lda, ldb; };

struct StaticOrder {
    int nM, nN, nwg, G, c; int skipctx = 0;
    __host__ __device__ void init(int M, int N, int G_, int c_) { nM = M / BM; nN = N / BM; nwg = nM * nN; G = G_; c = c_; }
    __host__ __device__ bool next(int i, Unit& u) const {
        const long L = (long)i * G + c; if (L >= nwg) return false;
        int wgid = (int)L; { const int q = nwg / NXCD, r = nwg % NXCD, xcd = wgid % NXCD, off = wgid / NXCD; wgid = (xcd < r ? xcd * (q + 1) : r * (q + 1) + (xcd - r) * q) + off; }
        const int nig = WGM * nN, gid = wgid / nig, fm = gid * WGM, gsz = (nM - fm) < WGM ? (nM - fm) : WGM;
        u.pm = fm + ((wgid % nig) % gsz); u.pn = (wgid % nig) / gsz; if (skipctx && u.pm >= 32) u.pm += 1; return true;
    }
    __device__ __forceinline__ void a_ready(const Unit&) const {}
    __device__ __forceinline__ void done(const Unit&) const {}
};
__device__ __forceinline__ unsigned cvt_pk_bf16(float lo, float hi) { unsigned r; asm volatile("v_cvt_pk_bf16_f32 %0, %1, %2" : "=v"(r) : "v"(lo), "v"(hi)); return r; }
struct EpiStoreBf16 {
    static constexpr bool PERM = true, AFTER_DRAIN = false;
    bf16_t* O; int ldc; int sc_lo, sc_hi; float sc;
    __device__ __forceinline__ void operator()(const f32x4 (&acc)[2][2][4][2], const Unit& u, int wr, int wc, int fr, int fq) const {
        const int row0 = u.pm * BM + wr * 64 + fr, colt = u.pn * BM, col0 = colt + wc * 32 + 8 * fq;
        const float s = (colt >= sc_lo && colt < sc_hi) ? sc : ((colt >= 4096) ? -1.4426950408889634f : 1.0f);
#pragma unroll
        for (int ai = 0; ai < 2; ++ai)
#pragma unroll
            for (int m = 0; m < 4; ++m) { bf16_t* rowp = O + (size_t)(row0 + ai * HALF + m * 16) * ldc + col0;
#pragma unroll
                for (int bj = 0; bj < 2; ++bj) { const f32x4 v0 = acc[ai][bj][m][0] * s, v1 = acc[ai][bj][m][1] * s;
                    u32x4 w; w.x = cvt_pk_bf16(v0[0], v0[1]); w.y = cvt_pk_bf16(v0[2], v0[3]); w.z = cvt_pk_bf16(v1[0], v1[1]); w.w = cvt_pk_bf16(v1[2], v1[3]);
                    *(u32x4*)(rowp + bj * HALF) = w; } }
    }
};

struct EpiOutResid {
    static constexpr bool PERM = true, AFTER_DRAIN = false;
    float* X; const float* gate3;
    const float* xin; const float* cin;
    __device__ __forceinline__ void operator()(const f32x4 (&acc_)[2][2][4][2], const Unit& u, int wr, int wc, int fr, int fq) const {
        f32x4 (&acc)[2][2][4][2] = const_cast<f32x4 (&)[2][2][4][2]>(acc_);
        const int rowp = u.pm * BM, b = rowp / 8448, tb = rowp % 8448, vs = (tb < 8192) ? b : 2;
        const int row0 = rowp + wr * 64 + fr, col0 = u.pn * BM + wc * 32 + 8 * fq;
        const float* gp = gate3 + (size_t)vs * 3072 + col0;
#pragma unroll
        for (int bj = 0; bj < 2; ++bj) { const f32x4 g0 = *(const f32x4*)(gp + bj * HALF), g1 = *(const f32x4*)(gp + bj * HALF + 4);
#pragma unroll
            for (int ai = 0; ai < 2; ++ai)
#pragma unroll
                for (int m = 0; m < 4; ++m) { acc[ai][bj][m][0] = acc[ai][bj][m][0] * g0; acc[ai][bj][m][1] = acc[ai][bj][m][1] * g1; } }
        const float al = xin ? 1.6817928305074290f : 1.0f;
        const float* sbase = xin ? ((tb < 8192) ? xin + (size_t)(b * 8192 + tb + wr * 64 + fr) * 1024 : cin + (size_t)(b * 256 + (tb - 8192) + wr * 64 + fr) * 1024) : X + (size_t)row0 * 1024;
        float* dbase = X + (size_t)row0 * 1024;
#pragma unroll
        for (int bj = 0; bj < 2; ++bj)
#pragma unroll
            for (int ai = 0; ai < 2; ++ai)
#pragma unroll
                for (int mh = 0; mh < 2; ++mh) {
                    f32x4 x0[2], x1[2];
#pragma unroll
                    for (int mm = 0; mm < 2; ++mm) { const int ro = (ai * HALF + (2 * mh + mm) * 16) * 1024 + col0 + bj * HALF; x0[mm] = *(const f32x4*)(sbase + ro); x1[mm] = *(const f32x4*)(sbase + ro + 4); }
#pragma unroll
                    for (int mm = 0; mm < 2; ++mm) { const int m = 2 * mh + mm; const int ro = (ai * HALF + m * 16) * 1024 + col0 + bj * HALF;
                        *(f32x4*)(dbase + ro) = x0[mm] * al + acc[ai][bj][m][0]; *(f32x4*)(dbase + ro + 4) = x1[mm] * al + acc[ai][bj][m][1]; } }
    }
};

struct EpiOutPart {
    static constexpr bool PERM = true, AFTER_DRAIN = false;
    float* XPs; const float* gate;
    __device__ __forceinline__ void operator()(const f32x4 (&acc)[2][2][4][2], const Unit& u, int wr, int wc, int fr, int fq) const {
        const int row0 = (u.pm == 32 ? 0 : 256) + wr * 64 + fr, col0 = u.pn * BM + wc * 32 + 8 * fq;
#pragma unroll
        for (int bj = 0; bj < 2; ++bj) { const f32x4 g0 = *(const f32x4*)(gate + col0 + bj * HALF), g1 = *(const f32x4*)(gate + col0 + bj * HALF + 4);
#pragma unroll
            for (int ai = 0; ai < 2; ++ai)
#pragma unroll
                for (int m = 0; m < 4; ++m) { float* xp = XPs + (size_t)(row0 + ai * HALF + m * 16) * 1024 + col0 + bj * HALF;
                    *(f32x4*)xp = g0 * acc[ai][bj][m][0]; *(f32x4*)(xp + 4) = g1 * acc[ai][bj][m][1]; } }
    }
};
struct CtxOrder {
    int j;
    __device__ __forceinline__ bool next(int i, Unit& u) const { if (i != 0 || j < 0 || j >= 8) return false; u.pm = (j < 4) ? 32 : 65; u.pn = j & 3; return true; }
    __device__ __forceinline__ void a_ready(const Unit&) const {}
    __device__ __forceinline__ void done(const Unit&) const {}
};
__device__ __forceinline__ float pg_sig(float x) { return __builtin_amdgcn_rcpf(1.0f + __expf(-x)); }
__device__ __forceinline__ void pg_unpack8(const u32x4 w, float* f) { f[0] = __uint_as_float(w.x << 16); f[1] = __uint_as_float(w.x & 0xffff0000u); f[2] = __uint_as_float(w.y << 16); f[3] = __uint_as_float(w.y & 0xffff0000u);
    f[4] = __uint_as_float(w.z << 16); f[5] = __uint_as_float(w.z & 0xffff0000u); f[6] = __uint_as_float(w.w << 16); f[7] = __uint_as_float(w.w & 0xffff0000u); }
struct EpiGlu {
    static constexpr bool PERM = true, AFTER_DRAIN = false;
    bf16_t* Pb; int ldp, ycol, zcol; const float* bias;
    __device__ __forceinline__ void operator()(const f32x4 (&acc)[2][2][4][2], const Unit& u, int wr, int wc, int fr, int fq) const {
        const int row0 = u.pm * BM + wr * 64 + fr, col0 = u.pn * BM + wc * 32 + 8 * fq;
#pragma unroll
        for (int bj = 0; bj < 2; ++bj) { const f32x4 b0 = *(const f32x4*)(bias + col0 + bj * HALF), b1 = *(const f32x4*)(bias + col0 + bj * HALF + 4);
#pragma unroll
            for (int ai = 0; ai < 2; ++ai)
#pragma unroll
                for (int mh = 0; mh < 2; ++mh) {
                    u32x4 yw[2], zw[2];
#pragma unroll
                    for (int mm = 0; mm < 2; ++mm) { const bf16_t* pr = Pb + (size_t)(row0 + ai * HALF + (2 * mh + mm) * 16) * ldp + col0 + bj * HALF; yw[mm] = *(const u32x4*)(pr + ycol); zw[mm] = *(const u32x4*)(pr + zcol); }
#pragma unroll
                    for (int mm = 0; mm < 2; ++mm) { const int m = 2 * mh + mm; bf16_t* pr = Pb + (size_t)(row0 + ai * HALF + m * 16) * ldp + col0 + bj * HALF;
                        float y[8], z[8]; pg_unpack8(yw[mm], y); pg_unpack8(zw[mm], z);
                        const f32x4 a0 = acc[ai][bj][m][0] + b0, a1 = acc[ai][bj][m][1] + b1; float o[8];
#pragma unroll
                        for (int j = 0; j < 4; ++j) { o[j] = y[j] * pg_sig(a0[j]) * (z[j] * pg_sig(z[j])); o[4 + j] = y[4 + j] * pg_sig(a1[j]) * (z[4 + j] * pg_sig(z[4 + j])); }
                        u32x4 w; w.x = cvt_pk_bf16(o[0], o[1]); w.y = cvt_pk_bf16(o[2], o[3]); w.z = cvt_pk_bf16(o[4], o[5]); w.w = cvt_pk_bf16(o[6], o[7]);
                        *(u32x4*)(pr + zcol) = w; } } }
    }
};
struct EpiBranch {
    static constexpr bool PERM = true, AFTER_DRAIN = false;
    bf16_t* Mo; const bf16_t* G; int ldg; int first; const bf16_t* M2;
    __device__ __forceinline__ void operator()(const f32x4 (&acc)[2][2][4][2], const Unit& u, int wr, int wc, int fr, int fq) const {
        const int row0 = u.pm * BM + wr * 64 + fr, col0 = u.pn * BM + wc * 32 + 8 * fq;
#pragma unroll
        for (int ai = 0; ai < 2; ++ai)
#pragma unroll
            for (int bj = 0; bj < 2; ++bj) {
                u32x4 gw[4], mw[4], m2w[4];
#pragma unroll
                for (int m = 0; m < 4; ++m) { const size_t r = (size_t)(row0 + ai * HALF + m * 16);
                    gw[m] = *(const u32x4*)(G + r * ldg + col0 + bj * HALF);
                    mw[m] = first ? (u32x4){0u, 0u, 0u, 0u} : *(const u32x4*)(Mo + r * 1024 + col0 + bj * HALF);
                    m2w[m] = M2 ? *(const u32x4*)(M2 + r * 1024 + col0 + bj * HALF) : (u32x4){0u, 0u, 0u, 0u}; }
#pragma unroll
                for (int m = 0; m < 4; ++m) { const size_t r = (size_t)(row0 + ai * HALF + m * 16);
                    float gt[8], o[8], o2[8]; pg_unpack8(gw[m], gt); pg_unpack8(mw[m], o); pg_unpack8(m2w[m], o2);
#pragma unroll
                    for (int j = 0; j < 4; ++j) { o[j] += o2[j] + __builtin_amdgcn_rcpf(1.0f + __builtin_amdgcn_exp2f(gt[j])) * acc[ai][bj][m][0][j]; o[4 + j] += o2[4 + j] + __builtin_amdgcn_rcpf(1.0f + __builtin_amdgcn_exp2f(gt[4 + j])) * acc[ai][bj][m][1][j]; }
                    u32x4 w; w.x = cvt_pk_bf16(o[0], o[1]); w.y = cvt_pk_bf16(o[2], o[3]); w.z = cvt_pk_bf16(o[4], o[5]); w.w = cvt_pk_bf16(o[6], o[7]);
                    *(u32x4*)(Mo + r * 1024 + col0 + bj * HALF) = w; } }
    }
};

template <class Epi, class Sched, bool ALIGN_EPI = false, bool SP2 = false>
__device__ __forceinline__ void gemm_phase(PG8_LAS unsigned char* lds, const Gemm g, const Sched& S, const Epi& E) {
    const int tid = otid(), wid = __builtin_amdgcn_readfirstlane(tid >> 6), lane = tid & 63, wr = wid >> 2, wc = wid & 3, fr = lane & 15, fq = lane >> 4;
    const int K = g.K, nt = K / BK;
    unsigned voffA[2], voffB[2];
#pragma unroll
    for (int i = 0; i < 2; ++i) { int R, C; stage_rc(tid * 16 + i * 8192, R, C); const int Rb = Epi::PERM ? ((R & ~31) + perm32(R & 31)) : R;
        voffA[i] = (unsigned)(R * g.lda + C) * 2u; voffB[i] = (unsigned)(Rb * g.ldb + C) * 2u; }
    const size_t kstep = (size_t)(BK * 2);
    const size_t hstep = (size_t)HALF * g.ldb * 2;
    const size_t tstep = 2 * hstep;
    const size_t hstepA = (size_t)HALF * g.lda * 2, tstepA = 2 * hstepA;
    const unsigned ldsw = (unsigned)wid * 1024u;
    const int aoff = lds_byte(wr * 64 + fr, fq * 8), boff = lds_byte(wc * 32 + fr, fq * 8);
#define PG8_SA(b, h) (((b) * 2 + (h)) * HTB)
#define PG8_SB(b, h) ((4 + (b) * 2 + (h)) * HTB)
#define PG8_STAGE(bufoff, gbase, voff) do { _Pragma("unroll") for (int _i = 0; _i < 2; ++_i) \
        __builtin_amdgcn_global_load_lds((const unsigned*)((const char*)(gbase) + (voff)[_i]), (PG8_LAS unsigned*)(lds + (bufoff) + ldsw + _i * 8192), 16, 0, 0); } while (0)
#define PG8_LDA(dst, b, h) do { _Pragma("unroll") for (int m = 0; m < 4; ++m) _Pragma("unroll") for (int k = 0; k < 2; ++k) dst[m][k] = *(const PG8_LAS bf16x8*)(lds + PG8_SA(b, h) + aoff + m * 2048 + k * 1024); } while (0)
#define PG8_LDB(dst, b, h) do { _Pragma("unroll") for (int n = 0; n < 2; ++n) _Pragma("unroll") for (int k = 0; k < 2; ++k) dst[n][k] = *(const PG8_LAS bf16x8*)(lds + PG8_SB(b, h) + boff + n * 2048 + k * 1024); } while (0)
#define PG8_MMA(ai, bj, At, Bt) do { __builtin_amdgcn_s_setprio(1); _Pragma("unroll") for (int m = 0; m < 4; ++m) _Pragma("unroll") for (int n = 0; n < 2; ++n) _Pragma("unroll") for (int k = 0; k < 2; ++k) \
        acc[ai][bj][m][n] = __builtin_amdgcn_mfma_f32_16x16x32_bf16(Bt[n][k], At[m][k], acc[ai][bj][m][n], 0, 0, 0); __builtin_amdgcn_s_setprio(0); } while (0)
#define PG8_WAIT_V(n) asm volatile("s_waitcnt vmcnt(" #n ")" ::: "memory")
#define PG8_WAIT_L(n) asm volatile("s_waitcnt lgkmcnt(" #n ")" ::: "memory")
#define PG8_BAR __builtin_amdgcn_s_barrier()
#define PG8_SCHED __builtin_amdgcn_sched_barrier(0)
    Unit cur, nxt; nxt.pm = 0; nxt.pn = 0; int ui = 0;
    if (!S.next(0, cur)) return;
    f32x4 acc[2][2][4][2];
#pragma unroll
    for (int a = 0; a < 2; ++a)
#pragma unroll
        for (int b = 0; b < 2; ++b)
#pragma unroll
            for (int m = 0; m < 4; ++m)
#pragma unroll
                for (int n = 0; n < 2; ++n) acc[a][b][m][n] = (f32x4){0.f, 0.f, 0.f, 0.f};
    bf16x8 At[4][2], B0[2][2], B1[2][2];
    const char* cA = (const char*)g.A + (size_t)cur.pm * tstepA; const char* cB = (const char*)g.Bt + (size_t)cur.pn * tstep;
    S.a_ready(cur);
    if constexpr (SP2) {
        PG8_STAGE(PG8_SB(0, 0), cB, voffB); PG8_STAGE(PG8_SB(0, 1), cB + hstep, voffB); PG8_STAGE(PG8_SA(0, 0), cA, voffA); PG8_STAGE(PG8_SA(0, 1), cA + hstepA, voffA);
        if (wr == 1) PG8_BAR;
        PG8_WAIT_V(2); PG8_BAR;
        PG8_STAGE(PG8_SB(1, 0), cB + kstep, voffB); PG8_STAGE(PG8_SA(1, 0), cA + kstep, voffA); PG8_STAGE(PG8_SB(1, 1), cB + hstep + kstep, voffB);
        PG8_WAIT_V(6); PG8_BAR;
    } else {
        PG8_STAGE(PG8_SB(0, 0), cB, voffB); PG8_STAGE(PG8_SA(0, 0), cA, voffA); PG8_STAGE(PG8_SB(0, 1), cB + hstep, voffB); PG8_STAGE(PG8_SA(0, 1), cA + hstepA, voffA);
        if (wr == 1) PG8_BAR;
        PG8_WAIT_V(4); PG8_BAR;
        PG8_STAGE(PG8_SB(1, 0), cB + kstep, voffB); PG8_STAGE(PG8_SA(1, 0), cA + kstep, voffA); PG8_STAGE(PG8_SB(1, 1), cB + hstep + kstep, voffB);
        PG8_WAIT_V(6); PG8_BAR;
    }
    for (;;) {
        const bool has_next = S.next(ui + 1, nxt);
        const char* nA = has_next ? (const char*)g.A + (size_t)nxt.pm * tstepA : cA; const char* nB = has_next ? (const char*)g.Bt + (size_t)nxt.pn * tstep : cB;
        for (int t = 0; t < nt; t += 2) {
            const bool last = (t == nt - 2);
            const char* a1 = cA + (size_t)(t + 1) * kstep;
            const char* a2 = last ? nA : cA + (size_t)(t + 2) * kstep; const char* b2 = last ? nB : cB + (size_t)(t + 2) * kstep;
            const char* a3 = a2 + kstep; const char* b3 = b2 + kstep;
            if (last && has_next) S.a_ready(nxt);
            if constexpr (SP2) {
            PG8_LDB(B0, 0, 0); PG8_LDB(B1, 0, 1); PG8_SCHED; PG8_LDA(At, 0, 0); PG8_STAGE(PG8_SA(1, 1), a1 + hstepA, voffA);
            PG8_WAIT_V(8); PG8_WAIT_L(0); PG8_BAR; PG8_MMA(0, 0, At, B0); PG8_MMA(0, 1, At, B1); PG8_BAR; PG8_SCHED;
            PG8_LDA(At, 0, 1); PG8_STAGE(PG8_SB(0, 0), b2, voffB); PG8_STAGE(PG8_SB(0, 1), b2 + hstep, voffB); PG8_STAGE(PG8_SA(0, 0), a2, voffA);
            PG8_WAIT_V(8); PG8_WAIT_L(0); PG8_BAR; PG8_MMA(1, 0, At, B0); PG8_MMA(1, 1, At, B1); PG8_BAR; PG8_SCHED;
            PG8_LDB(B0, 1, 0); PG8_LDB(B1, 1, 1); PG8_SCHED; PG8_LDA(At, 1, 0); PG8_STAGE(PG8_SA(0, 1), a2 + hstepA, voffA);
            PG8_WAIT_V(8); PG8_WAIT_L(0); PG8_BAR; PG8_MMA(0, 0, At, B0); PG8_MMA(0, 1, At, B1); PG8_BAR; PG8_SCHED;
            PG8_LDA(At, 1, 1); PG8_STAGE(PG8_SB(1, 0), b3, voffB); PG8_STAGE(PG8_SB(1, 1), b3 + hstep, voffB); PG8_STAGE(PG8_SA(1, 0), a3, voffA);
            PG8_WAIT_V(8); PG8_WAIT_L(0); PG8_BAR; PG8_MMA(1, 0, At, B0); PG8_MMA(1, 1, At, B1); PG8_BAR; PG8_SCHED;
            } else {
            PG8_LDB(B0, 0, 0); PG8_SCHED; PG8_LDA(At, 0, 0); PG8_STAGE(PG8_SA(1, 1), a1 + hstepA, voffA);
            PG8_WAIT_L(8); PG8_BAR; PG8_WAIT_L(0); PG8_MMA(0, 0, At, B0); PG8_BAR; PG8_SCHED;
            PG8_LDB(B1, 0, 1); PG8_STAGE(PG8_SB(0, 0), b2, voffB);
            PG8_BAR; PG8_WAIT_L(0); PG8_MMA(0, 1, At, B1); PG8_BAR;
            PG8_LDA(At, 0, 1); PG8_STAGE(PG8_SA(0, 0), a2, voffA);
            PG8_BAR; PG8_WAIT_L(0); PG8_MMA(1, 0, At, B0); PG8_BAR; PG8_SCHED;
            PG8_STAGE(PG8_SB(0, 1), b2 + hstep, voffB);
            PG8_WAIT_V(6); PG8_BAR; PG8_MMA(1, 1, At, B1); PG8_BAR;
            PG8_LDB(B0, 1, 0); PG8_SCHED; PG8_LDA(At, 1, 0); PG8_STAGE(PG8_SA(0, 1), a2 + hstepA, voffA);
            PG8_WAIT_L(8); PG8_BAR; PG8_WAIT_L(0); PG8_MMA(0, 0, At, B0); PG8_BAR; PG8_SCHED;
            PG8_LDB(B1, 1, 1); PG8_STAGE(PG8_SB(1, 0), b3, voffB);
            PG8_BAR; PG8_WAIT_L(0); PG8_MMA(0, 1, At, B1); PG8_BAR;
            PG8_LDA(At, 1, 1); PG8_STAGE(PG8_SA(1, 0), a3, voffA);
            PG8_BAR; PG8_WAIT_L(0); PG8_MMA(1, 0, At, B0); PG8_BAR; PG8_SCHED;
            PG8_STAGE(PG8_SB(1, 1), b3 + hstep, voffB);
            PG8_WAIT_V(6); PG8_BAR; PG8_MMA(1, 1, At, B1); PG8_BAR;
            }
        }
        if constexpr (ALIGN_EPI) { if (wr == 0) PG8_BAR; }
        if constexpr (!Epi::AFTER_DRAIN) { E(acc, cur, wr, wc, fr, fq); S.done(cur); }
        if (!has_next) break;
#pragma unroll
        for (int a = 0; a < 2; ++a)
#pragma unroll
            for (int b = 0; b < 2; ++b)
#pragma unroll
                for (int m = 0; m < 4; ++m)
#pragma unroll
                    for (int n = 0; n < 2; ++n) acc[a][b][m][n] = (f32x4){0.f, 0.f, 0.f, 0.f};
        cur = nxt; cA = nA; cB = nB; ++ui;
        if constexpr (ALIGN_EPI) { if (wr == 1) PG8_BAR; }
    }
    PG8_WAIT_V(0);
    if constexpr (!ALIGN_EPI) { if (wr == 0) PG8_BAR; }
    PG8_BAR;
    if constexpr (Epi::AFTER_DRAIN) { E.fused(acc, cur, wr, wc, fr, fq, lds, wid, lane); S.done(cur); }
#undef PG8_SA
#undef PG8_SB
#undef PG8_STAGE
#undef PG8_LDA
#undef PG8_LDB
#undef PG8_MMA
#undef PG8_WAIT_V
#undef PG8_WAIT_L
#undef PG8_BAR
#undef PG8_SCHED
}
}

#define LAS __attribute__((address_space(3)))
#define XB_TMO      128
#define XB_XCNT(j)  (256  + 64 * (j))
#define XB_XSUB(j)  (1280 + 64 * (j))
#define XB_XGEN(j)  (2304 + 64 * (j))
#define XB_TOP      3328
#define XB_TOPGEN   3392
#define XCD_BAR_WORDS 3456
#define XB_SPIN_CAP (1u << 18)
__device__ __forceinline__ unsigned xb_ld(unsigned* p)              { return __hip_atomic_load(p, __ATOMIC_RELAXED, __HIP_MEMORY_SCOPE_AGENT); }
__device__ __forceinline__ unsigned xb_add(unsigned* p, unsigned v) { return __hip_atomic_fetch_add(p, v, __ATOMIC_RELAXED, __HIP_MEMORY_SCOPE_AGENT); }
__device__ __forceinline__ unsigned xb_xcc_id() { return (unsigned)__builtin_amdgcn_s_getreg((3 << 11) | 20) & 0xFu; }
#define XB_SPIN(cond, bar) do { unsigned _sp = 0; while (cond) { __builtin_amdgcn_s_sleep(1); \
    if ((++_sp & 255u) == 0u) { if (xb_ld(&(bar)[XB_TMO])) break; if (_sp > XB_SPIN_CAP) { atomicAdd(&(bar)[XB_TMO], 1u); break; } } } } while (0)
struct XcdBarrier { unsigned* bar; unsigned x; volatile LAS unsigned* st; };
__device__ __forceinline__ XcdBarrier xcd_barrier_post(unsigned* bar, volatile LAS unsigned* st) {
    XcdBarrier b; b.bar = bar; b.x = xb_xcc_id(); b.st = st;
    if (threadIdx.x == 0) (void)xb_add(&bar[XB_XCNT(b.x)], 1u);
    return b;
}
__device__ __forceinline__ void xcd_barrier_complete(unsigned* bar, unsigned x, unsigned& nloc, unsigned& nx) {
    const unsigned G = gridDim.x * gridDim.y * gridDim.z;
    unsigned sum, cnt, mine, sp = 0u;
    for (;;) {
        sum = 0u; cnt = 0u; mine = 0u;
#pragma unroll
        for (unsigned j = 0; j < 16; ++j) { const unsigned c = xb_ld(&bar[XB_XCNT(j)]); sum += c; cnt += (c > 0u) ? 1u : 0u; mine = (j == x) ? c : mine; }
        if (sum == G) break;
        __builtin_amdgcn_s_sleep(1);
        if ((++sp & 255u) == 0u) { if (xb_ld(&bar[XB_TMO])) break; if (sp > XB_SPIN_CAP) { atomicAdd(&bar[XB_TMO], 1u); break; } }
    }
    nloc = mine > 0u ? mine : 1u; nx = cnt > 0u ? cnt : 1u;
}
__device__ __forceinline__ void xcd_barrier(const XcdBarrier& b) {
    asm volatile("s_waitcnt vmcnt(0)" ::: "memory");
    __syncthreads();
    if (threadIdx.x == 0) {
        unsigned* bar = b.bar; asm volatile("" : "+s"(bar));
        unsigned bx = b.x; asm volatile("" : "+s"(bx));
        __builtin_amdgcn_s_waitcnt(0);
        unsigned nloc = b.st[0], nx = b.st[1];
        if (nloc == 0u) { xcd_barrier_complete(bar, bx, nloc, nx); b.st[0] = nloc; b.st[1] = nx; }
        const unsigned old = xb_add(&bar[XB_XSUB(bx)], 1u);
        const unsigned gen = old / nloc;
        if (old + 1u == (gen + 1u) * nloc) {
            __builtin_amdgcn_fence(__ATOMIC_RELEASE, "agent");
            asm volatile("s_waitcnt vmcnt(0)" ::: "memory");
            const unsigned og = xb_add(&bar[XB_TOP], 1u);
            const unsigned tg = og / nx;
            if (og + 1u == (tg + 1u) * nx) xb_add(&bar[XB_TOPGEN], 1u);
            else XB_SPIN(xb_ld(&bar[XB_TOPGEN]) == tg, bar);
            __builtin_amdgcn_fence(__ATOMIC_ACQUIRE, "agent");
            xb_add(&bar[XB_XGEN(bx)], 1u);
            asm volatile("s_waitcnt vmcnt(0)" ::: "memory");
        } else {
            XB_SPIN(xb_ld(&bar[XB_XGEN(bx)]) == gen, bar);
            __builtin_amdgcn_fence(__ATOMIC_ACQUIRE, "agent");
            asm volatile("s_waitcnt vmcnt(0)" ::: "memory");
        }
    }
    __syncthreads();
}

__global__ void __launch_bounds__(512) hybrid_fwd(Params p) {
  extern __shared__ __attribute__((aligned(16))) char lds[];
  cg::grid_group grid = cg::this_grid();
  const int blk = blockIdx.x, nblk = gridDim.x;
  if (threadIdx.x == 0) { ((volatile LAS unsigned*)(lds + LDS_XB))[0] = 0u; ((volatile LAS unsigned*)(lds + LDS_XB))[1] = 0u; }
  if (blk == 0) { unsigned* bw = (unsigned*)(p.ws + WS_BAR); for (int i = threadIdx.x; i < XCD_BAR_WORDS; i += 512) bw[i] = 0u; }
  __syncthreads();
#define PHASE_VARS \
  const int tid = otid(), lane = tid & 63, wid = tid >> 6; \
  const int gtid = blk * 512 + tid, gthreads = nblk * 512, gwave = blk * 8 + wid, nwave = nblk * 8; \
  unsigned char* ws = opq(p.ws); \
  float* MOD = (float*)(ws + WS_MOD); float* X = (float*)(ws + WS_X); bf16_t* H = (bf16_t*)(ws + WS_H); bf16_t* P = (bf16_t*)(ws + WS_P); \
  bf16_t* KB = (bf16_t*)(ws + WS_K); bf16_t* VMT = (bf16_t*)(ws + WS_VMT); bf16_t* VNT = (bf16_t*)(ws + WS_VNT); \
  (void)lane; (void)gtid; (void)gthreads; (void)gwave; (void)nwave; (void)MOD; (void)X; (void)H; (void)P; (void)KB; (void)VMT; (void)VNT;

  {
    PHASE_VARS
    float* sv = (float*)lds;
    float* red = (float*)lds + 3072;
    for (int i = tid; i < 3072; i += 512) { const int v = i >> 10, k = i & 1023; const float c = (v < 2) ? p.in[1][v * 1024 + k] : p.in[3][k]; sv[i] = siluf_(c); }
    __syncthreads();
    for (int it = blk; it < DEPTH * 48; it += nblk) {
      const int l = it / 48, cc = it % 48, col = cc * 64 + lane, ks = wid;
      const float* W = p.in[4] + (size_t)l * 1024 * 3072 + col;
      float a0 = 0.f, a1 = 0.f, a2 = 0.f;
#pragma unroll 16
      for (int k = ks * 128; k < ks * 128 + 128; ++k) { const float w = W[(size_t)k * 3072]; a0 += sv[k] * w; a1 += sv[1024 + k] * w; a2 += sv[2048 + k] * w; }
      red[(ks * 3 + 0) * 64 + lane] = a0; red[(ks * 3 + 1) * 64 + lane] = a1; red[(ks * 3 + 2) * 64 + lane] = a2;
      __syncthreads();
      if (tid < 192) { const int v = tid >> 6, c = tid & 63; float s = 0.f; for (int k = 0; k < 8; ++k) s += red[(k * 3 + v) * 64 + c]; MOD[(size_t)(l * 3 + v) * 3072 + cc * 64 + c] = s + p.in[5][l * 3072 + cc * 64 + c]; }
      __syncthreads();
    }
    convert_layer_weights(p, 0, gtid, gthreads, 2);
    for (int idx = gtid; idx < DEPTH * 2 * 32 * 64; idx += gthreads) {
      const int pp = idx & 63, dg = idx >> 6;
      const double dt = exp((double)p.in[9][dg]);
      const double lr = (double)p.in[7][idx], li = (double)p.in[8][idx];
      const double mag = exp(lr * dt), ar = mag * cos(li * dt), ai = mag * sin(li * dt);
      double pr = ar, pi = ai;
      for (int s = 0; s < 6; ++s) { const double nr = pr * pr - pi * pi, ni = 2.0 * pr * pi; pr = nr; pi = ni; }
      float* sa = (float*)(ws + WS_SA) + (size_t)idx * 4;
      sa[0] = (float)ar; sa[1] = (float)ai; sa[2] = (float)pr; sa[3] = (float)pi;
      const double nr = ar - 1.0, den = lr * lr + li * li;
      const double fr = (nr * lr + ai * li) / den, fi = (ai * lr - nr * li) / den;
      bf16_t* bb = (bf16_t*)(ws + WS_BBT) + (size_t)dg * 128 * 16;
      const float* bre = p.in[10] + (size_t)idx * 16; const float* bim = p.in[11] + (size_t)idx * 16;
      for (int i = 0; i < 16; ++i) {
        const double br = bre[i], bi = bim[i];
        bb[(size_t)pp * 16 + i] = (bf16_t)f2bf((float)(fr * br - fi * bi));
        bb[(size_t)(64 + pp) * 16 + i] = (bf16_t)f2bf((float)(fr * bi + fi * br));
      }
    }
    for (int idx = gtid; idx < DEPTH * 2 * 32 * 32 * 128; idx += gthreads) {
      const int pq = idx & 127, i = (idx >> 7) & 31, dg = idx >> 12;
      float v = 0.f;
      if (i < 16) { const size_t ci = ((size_t)dg * 16 + i) * 64 + (pq >> 1); v = (pq & 1) ? -p.in[13][ci] : p.in[12][ci]; }
      ((bf16_t*)(ws + WS_CCT))[idx] = (bf16_t)f2bf(v);
    }
    for (int idx = gtid; idx < 128 * 8; idx += gthreads) {
      const int pos = idx >> 3, i = idx & 7;
      const double inv = pow(10000.0, -(double)i / 8.0), ang = (double)pos * inv;
      float* rt = (float*)(ws + WS_ROPE) + idx * 2; rt[0] = (float)cos(ang); rt[1] = (float)sin(ang);
    }
  }
  grid.sync();
  const XcdBarrier xb = xcd_barrier_post((unsigned*)(p.ws + WS_BAR), (volatile LAS unsigned*)(lds + LDS_XB));
  {
  PHASE_VARS
  for (int n = gwave; n < NTOK; n += nwave) {
    const int b = n / TB, t = n % TB, vs = (t < SEQ) ? b : 2;
    const float* md = MOD + (size_t)vs * 3072;
    f32x4 v[4];
    const float* xin = (t < SEQ) ? p.in[0] + (size_t)(b * SEQ + t) * 1024 : p.in[2] + (size_t)(b * CTX + (t - SEQ)) * 1024;
#pragma unroll
    for (int i = 0; i < 4; ++i) v[i] = *(const f32x4*)(xin + lane * 4 + 256 * i);
    wave_ln(v);
#pragma unroll
    for (int i = 0; i < 4; ++i) {
      const int c = lane * 4 + 256 * i;
      const f32x4 sh = *(const f32x4*)(md + c), sc = *(const f32x4*)(md + 1024 + c);
      const f32x4 h = v[i] * (sc + 1.0f) + sh;
      u32x2 w; w[0] = pk2(h[0], h[1]); w[1] = pk2(h[2], h[3]);
      *(u32x2*)(H + (size_t)n * 1024 + c) = w;
    }
  }
  }
  xcd_barrier(xb);

  for (int l = 0; l < DEPTH; ++l) {
    const bool need_ctx = (l < DEPTH - 1);
    {
      PHASE_VARS
      pg8::Gemm g{H, (const bf16_t*)(ws + WS_WIN), NTOK, NP, 1024, 1024, 1024};
      pg8::StaticOrder S; S.init(NTOK, NP, nblk, blk);
      pg8::EpiStoreBf16 E{P, NP, C_QN, C_KN, NA_QS};
      pg8::gemm_phase<pg8::EpiStoreBf16, pg8::StaticOrder, true, true>((PG8_LAS unsigned char*)lds, g, S, E);
    }
    xcd_barrier(xb);
    {
      PHASE_VARS
      bf16_t* Q = H;
      float* rstd = (float*)(lds + LDS_RSTD);
      const float* ROPE = (const float*)(ws + WS_ROPE);
      float* ropes = (float*)(lds + 143360);
      for (int i = tid; i < 128 * 16; i += 512) ropes[i] = ROPE[i];
      __syncthreads();
      for (int it = blk; it < 66 * 14; it += nblk) {
        const int tm = it / 14, tj = it % 14;
        const bool isq = tj < 6; const int tn = isq ? tj : tj - 6;
        const int row0 = tm * 256, Kd = isq ? 256 : 128, acol = isq ? C_CQ : C_CKV;
        const bf16_t* A = P + (size_t)row0 * NP + acol;
        {
          const int r = tid >> 1, hf = tid & 1; const bf16_t* ap = A + (size_t)r * NP + hf * (Kd >> 1);
          float s = 0.f;
          for (int c = 0; c < (Kd >> 1); c += 8) { float f[8]; unpack8(*(const u32x4*)(ap + c), f);
#pragma unroll
            for (int j = 0; j < 8; ++j) s += f[j] * f[j]; }
          s += __shfl_xor(s, 1);
          if (hf == 0) rstd[r] = 1.0f / sqrtf(s / (float)Kd + 1e-6f);
        }
        f32x16 acc[2][2]; zero_acc(acc);
        const bf16_t* Bt = isq ? (const bf16_t*)(ws + WS_WUQ) + (size_t)tn * 128 * 256 : (const bf16_t*)(ws + WS_WUKV) + (size_t)tn * 128 * 128;
        gemm_mainloop(lds, A, NP, Bt, Kd, Kd, acc);
        stage_acc(lds, acc);
        const int b = row0 / TB, tb = row0 % TB; const bool lat = tb < SEQ;
        if (isq) {
#pragma unroll
          for (int i = 0; i < 8; ++i) {
            int row, col; float v[8]; read_chunk(lds, i, row, col, v);
            const int gc = tn * 128 + col, j96 = gc % 96;
            const float rs = rstd[row] * MLA_QS;
            if (j96 >= 64 && lat) {
              const int jj = j96 - 64, axis = jj >> 4, second = (jj >> 3) & 1;
              const int t = tb + row, pos = axis == 0 ? (t >> 6) : (t & 63);
              const float* st = (const float*)lds + row * 132 + (second ? col - 8 : col + 8);
              const float* rt = ropes + pos * 16;
#pragma unroll
              for (int j = 0; j < 8; ++j) {
                const float cs_ = rt[2 * j], sn = rt[2 * j + 1], other = st[j];
                v[j] = second ? (other * sn + v[j] * cs_) : (v[j] * cs_ - other * sn);
              }
            }
#pragma unroll
            for (int j = 0; j < 8; ++j) v[j] *= rs;
            *(u32x4*)(Q + (size_t)(row0 + row) * 768 + gc) = pack8(v);
          }
        } else {
          const int h = tn;
#pragma unroll
          for (int i = 0; i < 4; ++i) {
            const int id = tid + 512 * i, row = id >> 3, col = (id & 7) * 8;
            const float* st = (const float*)lds + row * 132 + col; const float rs = rstd[row];
            float v[8];
#pragma unroll
            for (int j = 0; j < 8; ++j) v[j] = st[j] * rs;
            *(u32x4*)(KB + ((size_t)(row0 + row) * 8 + h) * 96 + col) = pack8(v);
          }
#pragma unroll
          for (int i = 0; i < 4; ++i) {
            const int id = tid + 512 * i, c = id & 63, rg = id >> 6;
            const float* st = (const float*)lds + (rg * 8) * 132 + 64 + c;
            float f[8];
#pragma unroll
            for (int j = 0; j < 8; ++j) f[j] = st[j * 132] * rstd[rg * 8 + j];
            *(u32x4*)(VMT + ((size_t)((b * 8 + h) * 64 + c)) * TB + tb + rg * 8) = pack8(f);
          }
        }
        __syncthreads();
      }
      for (int it = blk; it < NTOK / 64; it += nblk) {
        const int n0 = it * 64, b = n0 / TB, t0 = n0 % TB;
        bf16_t* tl = (bf16_t*)lds;
        u32x4 tv[8];
#pragma unroll
        for (int i = 0; i < 8; ++i) { const int id = tid + 512 * i, row = id >> 6, ch = id & 63; tv[i] = *(const u32x4*)(P + (size_t)(n0 + row) * NP + C_VN + ch * 8); }
#pragma unroll
        for (int i = 0; i < 8; ++i) { const int id = tid + 512 * i, row = id >> 6, ch = id & 63; *(u32x4*)(tl + row * 520 + ch * 8) = tv[i]; }
        __syncthreads();
#pragma unroll
        for (int rg = 0; rg < 8; ++rg) {
          u32x4 w;
#pragma unroll
          for (int j = 0; j < 4; ++j) w[j] = (unsigned)tl[(rg * 8 + 2 * j) * 520 + tid] | ((unsigned)tl[(rg * 8 + 2 * j + 1) * 520 + tid] << 16);
          *(u32x4*)(VNT + (size_t)(b * 512 + tid) * TB + t0 + rg * 8) = w;
        }
        __syncthreads();
      }
      for (int idx = gtid; idx < NTOK * 2; idx += gthreads) {
        const int n = idx >> 1, axis = idx & 1, t = n % TB;
        const bf16_t* kr = P + (size_t)n * NP + C_KR + axis * 16;
        float x1[8], x2[8], o1[8], o2[8];
        unpack8(*(const u32x4*)kr, x1); unpack8(*(const u32x4*)(kr + 8), x2);
        if (t < SEQ) {
          const int pos = axis == 0 ? (t >> 6) : (t & 63); const float* rt = ROPE + pos * 16;
#pragma unroll
          for (int j = 0; j < 8; ++j) { const float c = rt[2 * j], s = rt[2 * j + 1]; o1[j] = x1[j] * c - x2[j] * s; o2[j] = x1[j] * s + x2[j] * c; }
        } else {
#pragma unroll
          for (int j = 0; j < 8; ++j) { o1[j] = x1[j]; o2[j] = x2[j]; }
        }
        const u32x4 w1 = pack8(o1), w2 = pack8(o2);
#pragma unroll
        for (int h = 0; h < 8; ++h) { bf16_t* kp = KB + ((size_t)n * 8 + h) * 96 + 64 + axis * 16; *(u32x4*)kp = w1; *(u32x4*)(kp + 8) = w2; }
      }
      for (int it = nwave - 1 - gwave; it < 2 * 32 * NCH; it += nwave) { const int m = it % NCH, bg = it / NCH; s5_item(p, l, bg >> 5, bg & 31, m, 0, lds + wid * S5_WLDS); }
    }
    xcd_barrier(xb);
    {
      PHASE_VARS
      if (l + 1 < DEPTH && blk >= 16) convert_layer_weights(p, l + 1, (blk - 16) * 512 + tid, (nblk - 16) * 512, 0);
      if (gwave < 128) {
        const int d = gwave >> 6, g = gwave & 31;
        const f32x4 av = *(const f32x4*)((const float*)(ws + WS_SA) + ((size_t)((l * 2 + d) * 32 + g) * 64 + lane) * 4);
        float* Ed = (float*)(ws + WS_E) + (size_t)gwave * NCH * 128 + lane;
        float sr = 0.f, si = 0.f;
#pragma unroll 1
        for (int c0 = 0; c0 < NCH; c0 += 12) {
          float er[12], ei[12];
#pragma unroll
          for (int j = 0; j < 12; ++j) { er[j] = Ed[(size_t)(c0 + j) * 128]; ei[j] = Ed[(size_t)(c0 + j) * 128 + 64]; }
#pragma unroll
          for (int j = 0; j < 12; ++j) {
            Ed[(size_t)(c0 + j) * 128] = sr; Ed[(size_t)(c0 + j) * 128 + 64] = si;
            const float nr = av[2] * sr - av[3] * si + er[j], ni = av[2] * si + av[3] * sr + ei[j];
            sr = nr; si = ni;
          }
        }
      }
    }
    xcd_barrier(xb);
    {
#if EN_NA
      {
        PHASE_VARS
        float* rpbs = (float*)(lds + LDS_RPB);
#pragma unroll 1
        for (int j = 0; j < 3; ++j) {
          int bh, tok0, ntile, nwin, klo, qrow, qc0;
          if (j < 2) {
            const int rg = blk >> 3; if (rg >= 32) continue;
            bh = (blk & 7) + 8 * j;
            const int r0 = rg * 4;
            klo = min(max(r0 - 4, 0), 120); const int khi = min(max(r0 + 3 - 4, 0), 120) + 7; nwin = khi - klo + 1; ntile = nwin + 4;
            tok0 = (bh >> 3) * TB + r0 * 64 + 32 * wid; qrow = r0 + (wid >> 1); qc0 = 32 * (wid & 1);
          } else {
            if (!need_ctx || blk < 16 || blk >= 32) continue;
            bh = blk - 16; tok0 = (bh >> 3) * TB + SEQ + 32 * wid; ntile = 4; nwin = 0; klo = 0; qrow = 0; qc0 = 0;
          }
          const int b = bh >> 3, h = bh & 7;
          for (int i = tid; i < 465; i += 512) rpbs[i] = p.in[17][(size_t)(l * 8 + h) * 465 + i] * LOG2E;
          __syncthreads();
          attn_unit<64, true>(lds, P + (size_t)tok0 * NP + C_QN + h * 64, NP, P + (size_t)(b * TB) * NP + C_KN + h * 64, NP,
                              VNT + (size_t)((b * 8 + h) * 64) * TB, ntile, nwin, klo, qrow, qc0, P + (size_t)tok0 * NP + C_ZN + h * 64);
          __syncthreads();
        }
      }
#endif
#if EN_MLA
      {
        PHASE_VARS
        const bf16_t* Q = H;
#pragma unroll 1
        for (int j = 0; j < 3; ++j) {
          int bh, tok0, ntile, nwin;
          if (j < 2) {
            const int qb = blk >> 3; if (qb >= 32) continue;
            bh = (blk & 7) + 8 * j; tok0 = (bh >> 3) * TB + qb * 256 + 32 * wid; ntile = 132; nwin = 132;
          } else {
            if (!need_ctx || blk >= 16) continue;
            bh = blk; tok0 = (bh >> 3) * TB + SEQ + 32 * wid; ntile = 4; nwin = 0;
          }
          const int b = bh >> 3, h = bh & 7;
          attn_unit<96, false>(lds, Q + (size_t)tok0 * 768 + h * 96, 768, KB + (size_t)(b * TB) * 768 + h * 96, 768,
                               VMT + (size_t)((b * 8 + h) * 64) * TB, ntile, nwin, 0, 0, 0, P + (size_t)tok0 * NP + C_ZM + h * 64);
          __syncthreads();
        }
      }
#endif
#if EN_S5C
      {
        PHASE_VARS
        const int nch = need_ctx ? NCH : 128;
        for (int it = nwave - 1 - gwave; it < 2 * 32 * nch; it += nwave) { const int m = it % nch, bg = it / nch; s5_item(p, l, bg >> 5, bg & 31, m, 1, lds + wid * S5_WLDS); }
        __syncthreads();
      }
#endif
    }
    xcd_barrier(xb);
    {
      PHASE_VARS
      const int rows = need_ctx ? NTOK : 2 * SEQ;
#pragma unroll 1
      for (int br = 1; br < 3; ++br) {
        const int acol = br == 1 ? C_ZN : C_ZM;
        pg8::Gemm g{P + acol, (const bf16_t*)(ws + WS_WBR) + (size_t)br * 1024 * 512, rows, 1024, 512, NP, 512};
        pg8::StaticOrder S; S.init(rows, 1024, nblk, br == 1 ? blk : (blk + nblk - 8) % nblk); S.skipctx = need_ctx ? 0 : 1;
        pg8::EpiBranch E{br == 1 ? H : (bf16_t*)(ws + WS_K), P + C_GA + br * 1024, NP, 1, nullptr};
        pg8::gemm_phase<pg8::EpiBranch, pg8::StaticOrder, true, true>((PG8_LAS unsigned char*)lds, g, S, E);
        __syncthreads();
      }
      {
        pg8::Gemm g{P + C_UA, (const bf16_t*)(ws + WS_WGLU), rows, 512, 512, NP, 512};
        pg8::StaticOrder S; S.init(rows, 512, nblk, nblk - 1 - blk); S.skipctx = need_ctx ? 0 : 1;
        pg8::EpiGlu E{P, NP, C_UA, C_ZA, p.in[16] + l * 512};
        pg8::gemm_phase<pg8::EpiGlu, pg8::StaticOrder, true, true>((PG8_LAS unsigned char*)lds, g, S, E);
      }
    }
    xcd_barrier(xb);
    {
      PHASE_VARS
      const int rows = need_ctx ? NTOK : 2 * SEQ;
      pg8::Gemm g{P + C_ZA, (const bf16_t*)(ws + WS_WBR), rows, 1024, 512, NP, 512};
      pg8::StaticOrder S; S.init(rows, 1024, nblk, blk); S.skipctx = need_ctx ? 0 : 1;
      pg8::EpiBranch E{H, P + C_GA, NP, 0, (const bf16_t*)(ws + WS_K)};
      pg8::gemm_phase<pg8::EpiBranch, pg8::StaticOrder, true, true>((PG8_LAS unsigned char*)lds, g, S, E);
    }
    xcd_barrier(xb);
    {
      PHASE_VARS
      {
        pg8::Gemm g{H, (const bf16_t*)(ws + WS_WOUT), 2 * SEQ, 1024, 1024, 1024, 1024};
        pg8::StaticOrder S; S.init(2 * SEQ, 1024, nblk, blk); S.skipctx = 1;
        pg8::EpiOutResid E{X, MOD + (size_t)l * 3 * 3072 + 2048, l == 0 ? p.in[0] : nullptr, l == 0 ? p.in[2] : nullptr};
        pg8::gemm_phase<pg8::EpiOutResid, pg8::StaticOrder, true, true>((PG8_LAS unsigned char*)lds, g, S, E);
      }
    }
    if (need_ctx) {
      __syncthreads();
      PHASE_VARS
      const int s = (blk >> 3) & 3;
      pg8::Gemm g{H + s * 256, (const bf16_t*)(ws + WS_WOUT) + s * 256, NTOK, 1024, 256, 1024, 1024};
      pg8::CtxOrder S{blk < 32 ? (blk & 7) : -1};
      pg8::EpiOutPart E{(float*)(ws + WS_XP) + (size_t)s * 512 * 1024, MOD + (size_t)(l * 3 + 2) * 3072 + 2048};
      pg8::gemm_phase<pg8::EpiOutPart, pg8::CtxOrder, true, true>((PG8_LAS unsigned char*)lds, g, S, E);
    }
    xcd_barrier(xb);
    {
      PHASE_VARS
      const float* lg = p.in[26] + l * 1024; const float* lb = p.in[27] + l * 1024;
      const bool last = (l == DEPTH - 1);
#define P7_SKIP(n_) (last && ((n_) % TB) >= SEQ)
      int n = gwave; while (n < NTOK && P7_SKIP(n)) n += nwave;
      f32x4 nv[4];
#pragma unroll
      for (int i = 0; i < 4; ++i) nv[i] = (f32x4){0.f, 0.f, 0.f, 0.f};
      if (n < NTOK) {
#pragma unroll
        for (int i = 0; i < 4; ++i) nv[i] = *(const f32x4*)(X + (size_t)n * 1024 + lane * 4 + 256 * i);
      }
      while (n < NTOK) {
        asm volatile("" ::: "memory");
        const int b = n / TB, t = n % TB, vs = (t < SEQ) ? b : 2;
        f32x4 v[4];
#pragma unroll
        for (int i = 0; i < 4; ++i) v[i] = nv[i];
        int nn = n + nwave; while (nn < NTOK && P7_SKIP(nn)) nn += nwave;
        if (nn < NTOK) {
#pragma unroll
          for (int i = 0; i < 4; ++i) nv[i] = *(const f32x4*)(X + (size_t)nn * 1024 + lane * 4 + 256 * i);
        }
        if (t >= SEQ) {
          const size_t cr = (size_t)(b * CTX + (t - SEQ)) * 1024;
          const float* xp0 = (const float*)(ws + WS_XP) + cr;
#pragma unroll
          for (int i = 0; i < 4; ++i) {
            const int c = lane * 4 + 256 * i;
            f32x4 base = v[i];
            if (l == 0) base = *(const f32x4*)(p.in[2] + cr + c) * DN_ALPHA;
            v[i] = base + ((*(const f32x4*)(xp0 + c) + *(const f32x4*)(xp0 + (size_t)512 * 1024 + c)) + (*(const f32x4*)(xp0 + (size_t)2 * 512 * 1024 + c) + *(const f32x4*)(xp0 + (size_t)3 * 512 * 1024 + c)));
          }
        }
        wave_ln(v);
#pragma unroll
        for (int i = 0; i < 4; ++i) { const int c = lane * 4 + 256 * i; v[i] = v[i] * *(const f32x4*)(lg + c) + *(const f32x4*)(lb + c); }
        if (last) {
#pragma unroll
          for (int i = 0; i < 4; ++i) *(f32x4*)(p.out + ((size_t)(b * SEQ + t)) * 1024 + lane * 4 + 256 * i) = v[i];
        } else {
#pragma unroll
          for (int i = 0; i < 4; ++i) *(f32x4*)(X + (size_t)n * 1024 + lane * 4 + 256 * i) = v[i] * DN_ALPHA;
          const float* md = MOD + (size_t)((l + 1) * 3 + vs) * 3072;
          wave_ln(v);
#pragma unroll
          for (int i = 0; i < 4; ++i) {
            const int c = lane * 4 + 256 * i;
            const f32x4 sh = *(const f32x4*)(md + c), sc = *(const f32x4*)(md + 1024 + c);
            const f32x4 h = v[i] * (sc + 1.0f) + sh;
            u32x2 w; w[0] = pk2(h[0], h[1]); w[1] = pk2(h[2], h[3]);
            *(u32x2*)(H + (size_t)n * 1024 + c) = w;
          }
        }
        n = nn;
      }
#undef P7_SKIP
      if (!last) convert_layer_weights(p, l + 1, gtid, gthreads, 1);
    }
    if (l + 1 < DEPTH) xcd_barrier(xb);
  }
}

extern "C" void kernel_launch(void* const* d_in, const int* in_sizes, int n_in, void* d_out, int out_size, void* d_ws, size_t ws_size, hipStream_t stream) {
  static int grid = 0;
  if (grid == 0) {
    int dev = 0, cus = 0, per_cu = 0;
    hipGetDevice(&dev);
    hipDeviceGetAttribute(&cus, hipDeviceAttributeMultiprocessorCount, dev);
    hipFuncSetAttribute((const void*)hybrid_fwd, hipFuncAttributeMaxDynamicSharedMemorySize, LDS_BYTES);
    hipOccupancyMaxActiveBlocksPerMultiprocessor(&per_cu, (const void*)hybrid_fwd, 512, LDS_BYTES);
    if (per_cu < 1) fprintf(stderr, "kernel_launch: occupancy query says %d blocks/CU\n", per_cu);
    (void)hipGetLastError();
    grid = cus > 0 ? cus : 256;
    if (ws_size < WS_END) { fprintf(stderr, "kernel_launch: workspace too small (%zu < %zu)\n", ws_size, (size_t)WS_END); grid = -1; }
  }
  if (grid < 0) return;
  Params p{};
  for (int i = 0; i < 28; ++i) p.in[i] = (const float*)d_in[i];
  p.out = (float*)d_out; p.ws = (unsigned char*)d_ws;
  void* args[] = {&p};
  hipError_t e = hipLaunchCooperativeKernel((const void*)hybrid_fwd, dim3(grid), dim3(512), args, LDS_BYTES, stream);
  if (e != hipSuccess) fprintf(stderr, "cooperative launch failed: %s (grid %d)\n", hipGetErrorString(e), grid);
}
```

```cpp
#include <hip/hip_runtime.h>
#include <hip/hip_cooperative_groups.h>
#include <cstdio>
#include <cstdint>
namespace cg = cooperative_groups;
#ifndef EN_NA
#define EN_NA 1
#endif
#ifndef EN_MLA
#define EN_MLA 1
#endif
#ifndef EN_CTXU
#define EN_CTXU 1
#endif
#ifndef EN_S5C
#define EN_S5C 1
#endif

typedef unsigned short bf16_t;
typedef short bf16x8 __attribute__((ext_vector_type(8)));
typedef float f32x16 __attribute__((ext_vector_type(16)));
typedef float f32x4 __attribute__((ext_vector_type(4)));
typedef unsigned u32x4 __attribute__((ext_vector_type(4)));
typedef unsigned u32x2 __attribute__((ext_vector_type(2)));

constexpr int DM = 1024, SEQ = 8192, CTX = 256, TB = SEQ + CTX, NTOK = 2 * TB, DEPTH = 4;
constexpr int NP = 7168;
constexpr int C_UA = 0, C_ZA = 512, C_QN = 1024, C_KN = 1536, C_VN = 2048, C_ZN = 2560, C_CQ = 3072, C_CKV = 3328, C_KR = 3456, C_ZM = 3584, C_GA = 4096;
constexpr int NCH = 132;
constexpr float LOG2E = 1.4426950408889634f;
constexpr float NA_QS = 0.125f * LOG2E;
constexpr float MLA_QS = 0.10206207261596577f * LOG2E;
constexpr float ATT_THR = 8.0f;
constexpr float DN_ALPHA = 1.6817928305074290f;

constexpr size_t MiB = 1u << 20;
constexpr size_t WS_MOD = 0;
constexpr size_t WS_ROPE = 256 * 1024;
constexpr size_t WS_SA = 512 * 1024;
constexpr size_t WS_BBT = 1 * MiB;
constexpr size_t WS_CCT = 2 * MiB;
constexpr size_t WS_BAR = 768 * 1024;
constexpr size_t WS_WIN = 4 * MiB;
constexpr size_t WS_WUQ = 18 * MiB;
constexpr size_t WS_WUKV = WS_WUQ + 512 * 1024;
constexpr size_t WS_WGLU = 19 * MiB;
constexpr size_t WS_WBR = 20 * MiB;
constexpr size_t WS_WOUT = 23 * MiB;
constexpr size_t WS_X = 25 * MiB;
constexpr size_t WS_H = 91 * MiB;
constexpr size_t WS_P = 124 * MiB;
constexpr size_t WS_K = 355 * MiB;
constexpr size_t WS_VMT = 380 * MiB;
constexpr size_t WS_VNT = 397 * MiB;
constexpr size_t WS_E = 414 * MiB;
constexpr size_t WS_XP = 423 * MiB;
constexpr size_t WS_END = 431 * MiB;

constexpr int LDS_STAGE = 135168;
constexpr int LDS_RSTD = LDS_STAGE;
constexpr int LDS_RPB = LDS_STAGE + 1024;
constexpr int LDS_BYTES = 155648;
constexpr int LDS_XB = LDS_BYTES - 16;

struct Params {
  const float* in[28];
  float* out;
  unsigned char* ws;
};

__device__ __forceinline__ float bf2f(unsigned short b) { return __uint_as_float(((unsigned)b) << 16); }
__device__ __forceinline__ unsigned f2bf(float f) { unsigned u = __float_as_uint(f); u += 0x7fffu + ((u >> 16) & 1u); return u >> 16; }
typedef float f32x2_t __attribute__((ext_vector_type(2))); typedef __bf16 bf16x2_t __attribute__((ext_vector_type(2)));
__device__ __forceinline__ unsigned pk2(float lo, float hi) { f32x2_t v = {lo, hi}; bf16x2_t b = __builtin_convertvector(v, bf16x2_t); return __builtin_bit_cast(unsigned, b); }
__device__ __forceinline__ void unpack8(const u32x4 w, float* f) {
#pragma unroll
  for (int i = 0; i < 4; ++i) { f[2 * i] = __uint_as_float(w[i] << 16); f[2 * i + 1] = __uint_as_float(w[i] & 0xffff0000u); }
}
__device__ __forceinline__ u32x4 pack8(const float* f) { u32x4 w; w[0] = pk2(f[0], f[1]); w[1] = pk2(f[2], f[3]); w[2] = pk2(f[4], f[5]); w[3] = pk2(f[6], f[7]); return w; }
__device__ __forceinline__ float sigmoidf_(float x) { return __builtin_amdgcn_rcpf(1.0f + __expf(-x)); }
__device__ __forceinline__ float siluf_(float x) { return x * __builtin_amdgcn_rcpf(1.0f + __expf(-x)); }
__device__ __forceinline__ float geluf_(float x) { const float u = 0.7978845608028654f * (x + 0.044715f * x * x * x); return x * __builtin_amdgcn_rcpf(1.0f + __expf(-2.0f * u)); }
__device__ __forceinline__ int crow(int r, int hi) { return (r & 3) + 8 * (r >> 2) + 4 * hi; }
__device__ __forceinline__ float xhalf(float v) { return __shfl_xor(v, 32); }
__device__ __forceinline__ float xhalf_max(float v) { auto rr = __builtin_amdgcn_permlane32_swap(__float_as_uint(v), __float_as_uint(v), false, false); return fmaxf(__uint_as_float(rr[0]), __uint_as_float(rr[1])); }
__device__ __forceinline__ bf16x8 as_bf16x8(u32x4 w) { return __builtin_bit_cast(bf16x8, w); }
__device__ __forceinline__ int otid() { int t = threadIdx.x; asm volatile("" : "+v"(t)); return t; }
__device__ __forceinline__ unsigned char* opq(unsigned char* x) { asm volatile("" : "+s"(x)); return x; }
#define MFMA32(a, b, c) __builtin_amdgcn_mfma_f32_32x32x16_bf16((a), (b), (c), 0, 0, 0)
#define WAVE_LDS_FENCE() asm volatile("s_waitcnt lgkmcnt(0)" ::: "memory")

__device__ __forceinline__ void gemm_mainloop(char* lds, const bf16_t* A, int lda, const bf16_t* Bt, int ldb, int K, f32x16 (&acc)[2][2]) {
  const int tid = otid(), lane = tid & 63, wid = tid >> 6, wm = wid >> 1, wn = wid & 1, l31 = lane & 31, hh = lane >> 5;
  const int lr = tid >> 3, lc = tid & 7;
  const bf16_t* ga = A + (size_t)lr * lda + lc * 8;
  const bf16_t* gb = Bt + (size_t)lr * ldb + lc * 8;
  u32x4 ra0, ra1, ra2, ra3, rb0, rb1;
  ra0 = *(const u32x4*)(ga); ra1 = *(const u32x4*)(ga + (size_t)64 * lda); ra2 = *(const u32x4*)(ga + (size_t)128 * lda); ra3 = *(const u32x4*)(ga + (size_t)192 * lda);
  rb0 = *(const u32x4*)(gb); rb1 = *(const u32x4*)(gb + (size_t)64 * ldb);
  const int woff = lr * 144 + lc * 16;
  {
    char* As = lds; char* Bs = lds + 36864;
    *(u32x4*)(As + woff) = ra0; *(u32x4*)(As + woff + 64 * 144) = ra1; *(u32x4*)(As + woff + 128 * 144) = ra2; *(u32x4*)(As + woff + 192 * 144) = ra3;
    *(u32x4*)(Bs + woff) = rb0; *(u32x4*)(Bs + woff + 64 * 144) = rb1;
  }
  __syncthreads();
  const int nk = K >> 6;
  const int aoff = (wm * 64 + l31) * 144 + hh * 16, boff = (wn * 64 + l31) * 144 + hh * 16;
  for (int kt = 0; kt < nk; ++kt) {
    const int st = kt & 1;
    const bool more = (kt + 1 < nk);
    if (more) {
      const int k0 = (kt + 1) * 64;
      ra0 = *(const u32x4*)(ga + k0); ra1 = *(const u32x4*)(ga + (size_t)64 * lda + k0); ra2 = *(const u32x4*)(ga + (size_t)128 * lda + k0); ra3 = *(const u32x4*)(ga + (size_t)192 * lda + k0);
      rb0 = *(const u32x4*)(gb + k0); rb1 = *(const u32x4*)(gb + (size_t)64 * ldb + k0);
    }
    const char* As = lds + st * 55296; const char* Bs = As + 36864;
#pragma unroll
    for (int ks = 0; ks < 4; ++ks) {
      const bf16x8 a0 = *(const bf16x8*)(As + aoff + ks * 32), a1 = *(const bf16x8*)(As + aoff + 32 * 144 + ks * 32);
      const bf16x8 b0 = *(const bf16x8*)(Bs + boff + ks * 32), b1 = *(const bf16x8*)(Bs + boff + 32 * 144 + ks * 32);
      acc[0][0] = MFMA32(a0, b0, acc[0][0]); acc[0][1] = MFMA32(a0, b1, acc[0][1]);
      acc[1][0] = MFMA32(a1, b0, acc[1][0]); acc[1][1] = MFMA32(a1, b1, acc[1][1]);
    }
    if (more) {
      char* Aw = lds + (st ^ 1) * 55296; char* Bw = Aw + 36864;
      *(u32x4*)(Aw + woff) = ra0; *(u32x4*)(Aw + woff + 64 * 144) = ra1; *(u32x4*)(Aw + woff + 128 * 144) = ra2; *(u32x4*)(Aw + woff + 192 * 144) = ra3;
      *(u32x4*)(Bw + woff) = rb0; *(u32x4*)(Bw + woff + 64 * 144) = rb1;
    }
    __syncthreads();
  }
}
__device__ __forceinline__ void zero_acc(f32x16 (&acc)[2][2]) {
#pragma unroll
  for (int a = 0; a < 2; ++a)
#pragma unroll
    for (int b = 0; b < 2; ++b)
#pragma unroll
      for (int r = 0; r < 16; ++r) acc[a][b][r] = 0.f;
}
__device__ __forceinline__ void stage_acc(char* lds, const f32x16 (&acc)[2][2]) {
  const int tid = otid(), lane = tid & 63, wid = tid >> 6, wm = wid >> 1, wn = wid & 1, l31 = lane & 31, hh = lane >> 5;
  float* st = (float*)lds;
#pragma unroll
  for (int mi = 0; mi < 2; ++mi)
#pragma unroll
    for (int ni = 0; ni < 2; ++ni)
#pragma unroll
      for (int r = 0; r < 16; ++r) st[(wm * 64 + mi * 32 + crow(r, hh)) * 132 + wn * 64 + ni * 32 + l31] = acc[mi][ni][r];
  __syncthreads();
}
__device__ __forceinline__ void read_chunk(const char* lds, int i, int& row, int& col, float* v) {
  const int id = otid() + 512 * i; row = id >> 4; col = (id & 15) * 8;
  const float* st = (const float*)lds + row * 132 + col;
  const f32x4 x = *(const f32x4*)st, y = *(const f32x4*)(st + 4);
  v[0] = x[0]; v[1] = x[1]; v[2] = x[2]; v[3] = x[3]; v[4] = y[0]; v[5] = y[1]; v[6] = y[2]; v[7] = y[3];
}

__device__ __forceinline__ void wave_ln(f32x4 (&v)[4]) {
  float s = 0.f;
#pragma unroll
  for (int i = 0; i < 4; ++i) s += (v[i][0] + v[i][1]) + (v[i][2] + v[i][3]);
#pragma unroll
  for (int o = 32; o >= 1; o >>= 1) s += __shfl_xor(s, o);
  const float mean = s * (1.0f / 1024.0f);
  float q = 0.f;
#pragma unroll
  for (int i = 0; i < 4; ++i) { v[i] = v[i] - mean; q += (v[i][0] * v[i][0] + v[i][1] * v[i][1]) + (v[i][2] * v[i][2] + v[i][3] * v[i][3]); }
#pragma unroll
  for (int o = 32; o >= 1; o >>= 1) q += __shfl_xor(q, o);
  const float rstd = 1.0f / sqrtf(q * (1.0f / 1024.0f) + 1e-5f);
#pragma unroll
  for (int i = 0; i < 4; ++i) v[i] = v[i] * rstd;
}

__device__ __forceinline__ void convT(const float* __restrict__ src, int ldsrc, int K, int n0, int ncnt, bf16_t* __restrict__ dst, const float* __restrict__ kscale, int gtid, int gthreads) {
  const int total = ncnt * (K >> 3);
  int idx = gtid;
  for (; idx + gthreads < total; idx += 2 * gthreads) {
    const int i1 = idx + gthreads;
    const int na = idx % ncnt, ka = idx / ncnt, nb = i1 % ncnt, kb = i1 / ncnt;
    float fa[8], fb[8];
#pragma unroll
    for (int j = 0; j < 8; ++j) { fa[j] = src[(size_t)(ka * 8 + j) * ldsrc + n0 + na]; fb[j] = src[(size_t)(kb * 8 + j) * ldsrc + n0 + nb]; }
    if (kscale) {
#pragma unroll
      for (int j = 0; j < 8; ++j) { fa[j] *= kscale[ka * 8 + j]; fb[j] *= kscale[kb * 8 + j]; }
    }
    *(u32x4*)(dst + (size_t)na * K + ka * 8) = pack8(fa);
    *(u32x4*)(dst + (size_t)nb * K + kb * 8) = pack8(fb);
  }
  if (idx < total) {
    const int n = idx % ncnt, k8 = idx / ncnt;
    float f[8];
#pragma unroll
    for (int j = 0; j < 8; ++j) { f[j] = src[(size_t)(k8 * 8 + j) * ldsrc + n0 + n]; if (kscale) f[j] *= kscale[k8 * 8 + j]; }
    *(u32x4*)(dst + (size_t)n * K + k8 * 8) = pack8(f);
  }
}
__device__ void convert_layer_weights(const Params& p, int l, int gtid, int gthreads, int part) {
  unsigned char* ws = opq(p.ws);
  if (part != 1) {
    bf16_t* win = (bf16_t*)(ws + WS_WIN);
    const float* w_in = p.in[6] + (size_t)l * 1024 * 7072;
    convT(w_in, 7072, 1024, 0, 3488, win, nullptr, gtid, gthreads);
    for (int idx = gtid; idx < 96 * 128; idx += gthreads) { unsigned z0 = 0u; asm volatile("" : "+v"(z0)); *(u32x4*)(win + (size_t)3488 * 1024 + (size_t)idx * 8) = (u32x4){z0, z0, z0, z0}; }
    convT(w_in, 7072, 1024, 3488, 3584, win + (size_t)3584 * 1024, nullptr, gtid, gthreads);
    convT(p.in[19] + (size_t)l * 256 * 768, 768, 256, 0, 768, (bf16_t*)(ws + WS_WUQ), p.in[18] + l * 256, gtid, gthreads);
    convT(p.in[21] + (size_t)l * 128 * 1024, 1024, 128, 0, 1024, (bf16_t*)(ws + WS_WUKV), p.in[20] + l * 128, gtid, gthreads);
  }
  if (part != 0) {
    convT(p.in[15] + (size_t)l * 512 * 512, 512, 512, 0, 512, (bf16_t*)(ws + WS_WGLU), nullptr, gtid, gthreads);
    convT(p.in[22] + (size_t)l * 512 * 1024, 1024, 512, 0, 1024, (bf16_t*)(ws + WS_WBR), nullptr, gtid, gthreads);
    convT(p.in[23] + (size_t)l * 512 * 1024, 1024, 512, 0, 1024, (bf16_t*)(ws + WS_WBR) + (size_t)1024 * 512, nullptr, gtid, gthreads);
    convT(p.in[24] + (size_t)l * 512 * 1024, 1024, 512, 0, 1024, (bf16_t*)(ws + WS_WBR) + (size_t)2048 * 512, nullptr, gtid, gthreads);
    convT(p.in[25] + (size_t)l * 1024 * 1024, 1024, 1024, 0, 1024, (bf16_t*)(ws + WS_WOUT), nullptr, gtid, gthreads);
  }
}

constexpr int S5_WLDS = 18944;
__device__ void s5_item(const Params& p, int l, int b, int g, int m, int mode, char* wlds, int wofs = 0) {
  const int lane = otid() & 63, l31 = lane & 31, hh = lane >> 5;
  unsigned char* ws = opq(p.ws);
  bf16_t* P = (bf16_t*)(ws + WS_P);
  float* E = (float*)(ws + WS_E);
  char* BUT = wlds; char* ST = wlds + 10240;
  const int t0 = (m < 128) ? 64 * m : 8192 + 64 * (m - 128);
  bf16_t* U = P + (size_t)(b * TB + t0) * NP + C_UA + g * 16;
  f32x16 accY0, accY1;
#pragma unroll
  for (int r = 0; r < 16; ++r) { accY0[r] = 0.f; accY1[r] = 0.f; }
  const bf16x8 uf0 = as_bf16x8(*(const u32x4*)(U + (size_t)l31 * NP + 8 * hh));
  const bf16x8 uf1 = as_bf16x8(*(const u32x4*)(U + (size_t)(32 + l31) * NP + 8 * hh));
#pragma unroll 1
  for (int d = 0; d < 2; ++d) {
    const int cd = (m < 128) ? (d == 0 ? 4 + m : 4 + 127 - m) : (d == 0 ? (m - 128) : 3 - (m - 128));
    const int dg = ((l * 2 + d) * 32 + g);
    const f32x4 av = *(const f32x4*)((const float*)(ws + WS_SA) + ((size_t)dg * 64 + lane) * 4);
    const bf16_t* bbt = (const bf16_t*)(ws + WS_BBT) + (size_t)dg * 128 * 16 + (size_t)l31 * 16 + 8 * hh;
    const bf16_t* cct = (const bf16_t*)(ws + WS_CCT) + (size_t)dg * 32 * 128 + (size_t)l31 * 128 + 8 * hh;
    float* Ed = E + ((size_t)((d * 2 + b) * 32 + g) * NCH) * 128 + lane;
    bf16x8 bbf[4], ccf[8];
#pragma unroll
    for (int ni = 0; ni < 4; ++ni) bbf[ni] = as_bf16x8(*(const u32x4*)(bbt + (size_t)(32 * ni) * 16));
    if (mode == 1) {
#pragma unroll
      for (int ks = 0; ks < 8; ++ks) ccf[ks] = as_bf16x8(*(const u32x4*)(cct + 16 * ks));
    }
    float sr = 0.f, si = 0.f;
    if (mode == 1) { sr = Ed[(size_t)cd * 128]; si = Ed[(size_t)cd * 128 + 64]; }
#pragma unroll 1
    for (int ss = 0; ss < 2; ++ss) {
      const int sub = (d == 0) ? ss : 1 - ss;
      const bf16x8 uf = sub ? uf1 : uf0;
#pragma unroll
      for (int ni = 0; ni < 4; ++ni) {
        f32x16 z;
#pragma unroll
        for (int r = 0; r < 16; ++r) z[r] = 0.f;
        z = MFMA32(uf, bbf[ni], z);
        char* wp = BUT + (32 * ni + l31) * 80 + 8 * hh;
#pragma unroll
        for (int rg = 0; rg < 4; ++rg) { u32x2 w; w[0] = pk2(z[4 * rg], z[4 * rg + 1]); w[1] = pk2(z[4 * rg + 2], z[4 * rg + 3]); *(u32x2*)(wp + 16 * rg) = w; }
      }
      WAVE_LDS_FENCE();
#pragma unroll
      for (int hf = 0; hf < 2; ++hf) {
        const int base = (d == 0) ? 16 * hf : 16 * (1 - hf);
        const u32x4 ra = *(const u32x4*)(BUT + lane * 80 + base * 2), rb = *(const u32x4*)(BUT + lane * 80 + base * 2 + 16);
        const u32x4 ia = *(const u32x4*)(BUT + (64 + lane) * 80 + base * 2), ib = *(const u32x4*)(BUT + (64 + lane) * 80 + base * 2 + 16);
        float br[16], bi[16];
        unpack8(ra, br); unpack8(rb, br + 8); unpack8(ia, bi); unpack8(ib, bi + 8);
        if (d == 0) {
#pragma unroll
          for (int jj = 0; jj < 16; ++jj) { const float nr = av[0] * sr - av[1] * si + br[jj], ni = av[0] * si + av[1] * sr + bi[jj]; sr = nr; si = ni; br[jj] = nr; bi[jj] = ni; }
        } else {
#pragma unroll
          for (int jj = 15; jj >= 0; --jj) { const float nr = av[0] * sr - av[1] * si + br[jj], ni = av[0] * si + av[1] * sr + bi[jj]; sr = nr; si = ni; br[jj] = nr; bi[jj] = ni; }
        }
        if (mode == 1) {
#pragma unroll
          for (int jj = 0; jj < 16; ++jj) *(unsigned*)(ST + (base + jj) * 272 + lane * 4) = pk2(br[jj], bi[jj]);
        }
      }
      WAVE_LDS_FENCE();
      if (mode == 1) {
        f32x16 ay = sub ? accY1 : accY0;
#pragma unroll
        for (int ks = 0; ks < 8; ++ks) {
          const bf16x8 sf = *(const bf16x8*)(ST + l31 * 272 + (16 * ks + 8 * hh) * 2);
          ay = MFMA32(sf, ccf[ks], ay);
        }
        if (sub) accY1 = ay; else accY0 = ay;
        WAVE_LDS_FENCE();
      }
    }
    if (mode == 0) { Ed[(size_t)cd * 128] = sr; Ed[(size_t)cd * 128 + 64] = si; }
  }
  if (mode == 1 && l31 < 16) {
    const float dsk = p.in[14][l * 512 + g * 16 + l31];
    bf16_t* ub = U + (size_t)(4 * hh) * NP + l31;
    float uv[32];
#pragma unroll
    for (int r = 0; r < 16; ++r) { uv[r] = bf2f(ub[(size_t)((r & 3) + 8 * (r >> 2)) * NP]); uv[16 + r] = bf2f(ub[(size_t)(32 + (r & 3) + 8 * (r >> 2)) * NP]); }
#pragma unroll
    for (int r = 0; r < 16; ++r) {
      const float y0 = accY0[r] + dsk * uv[r], y1 = accY1[r] + dsk * uv[16 + r];
      ub[(size_t)((r & 3) + 8 * (r >> 2)) * NP + wofs] = (bf16_t)f2bf(geluf_(y0));
      ub[(size_t)(32 + (r & 3) + 8 * (r >> 2)) * NP + wofs] = (bf16_t)f2bf(geluf_(y1));
    }
  }
}

template <int DQK, bool NA>
__device__ void attn_unit(char* lds, const bf16_t* Qw, int ldq, const bf16_t* Kb, int ldk, const bf16_t* Vt,
                          int ntile, int nwin, int klo, int qrow, int qc0, bf16_t* Ow) {
  constexpr int NKS = DQK / 16, KCH = DQK / 8;
  const int tid = otid(), lane = tid & 63, l31 = lane & 31, hh = lane >> 5;
  const float* rpbs = (const float*)(lds + LDS_RPB);
  bf16x8 qf[NKS];
#pragma unroll
  for (int ks = 0; ks < NKS; ++ks) qf[ks] = as_bf16x8(*(const u32x4*)(Qw + (size_t)l31 * ldq + ks * 16 + hh * 8));
  f32x16 o0, o1;
#pragma unroll
  for (int r = 0; r < 16; ++r) { o0[r] = 0.f; o1[r] = 0.f; }
  float mrun = 0.f, lsum = 0.f; bool first = true;
  f32x16 negm;
#pragma unroll
  for (int r = 0; r < 16; ++r) negm[r] = 0.f;
  const int vdv = tid >> 3, vch = tid & 7;
  int kr0, kc0, kr1 = 0, kc1 = 0; bool k1on = false;
  if (KCH == 8) { kr0 = tid >> 3; kc0 = tid & 7; }
  else { kr0 = tid / 12; kc0 = tid % 12; const int id1 = tid + 512; k1on = id1 < 768; kr1 = id1 / 12; kc1 = id1 % 12; }
  u32x4 rk0, rk1 = (u32x4){0u, 0u, 0u, 0u}, rv;
  auto tile_t0 = [&](int i) -> int { return (i < nwin) ? (klo + i) * 64 : 8192 + (i - nwin) * 64; };
  auto gload = [&](int i) {
    const int t0 = tile_t0(i);
    rk0 = *(const u32x4*)(Kb + (size_t)(t0 + kr0) * ldk + kc0 * 8);
    if (KCH != 8 && k1on) rk1 = *(const u32x4*)(Kb + (size_t)(t0 + kr1) * ldk + kc1 * 8);
    rv = *(const u32x4*)(Vt + (size_t)vdv * TB + t0 + vch * 8);
  };
  auto swrite = [&](int st) {
    char* Ks = lds + st * 13312; char* Vs = lds + 26624 + st * 9216;
    *(u32x4*)(Ks + kr0 * 208 + kc0 * 16) = rk0;
    if (KCH != 8 && k1on) *(u32x4*)(Ks + kr1 * 208 + kc1 * 16) = rk1;
    { char* vr = Vs + vdv * 144 + (vch >> 1) * 32 + (vch & 1) * 8; *(u32x2*)(vr) = (u32x2){rv[0], rv[1]}; *(u32x2*)(vr + 16) = (u32x2){rv[2], rv[3]}; }
  };
  gload(0); swrite(0);
  __syncthreads();
  const int krs = NA ? min(max(qrow - 4, 0), 120) : 0;
  const int qc = qc0 + l31;
  const int cs = NA ? min(max(qc - 8, 0), 48) : 0;
  for (int i = 0; i < ntile; ++i) {
    const int st = i & 1;
    const bool more = (i + 1 < ntile);
    if (more) gload(i + 1);
    bool active = true; bool win = false; int kr = 0;
    if (NA && i < nwin) { kr = klo + i; win = true; active = (kr >= krs) && (kr < krs + 8); }
    if (active) {
      const char* Ks = lds + st * 13312; const char* Vs = lds + 26624 + st * 9216;
      f32x16 s0, s1;
      bf16x8 kf[2 * NKS];
#pragma unroll
      for (int ks = 0; ks < NKS; ++ks) { kf[2 * ks] = *(const bf16x8*)(Ks + l31 * 208 + ks * 32 + hh * 16); kf[2 * ks + 1] = *(const bf16x8*)(Ks + (32 + l31) * 208 + ks * 32 + hh * 16); }
      __builtin_amdgcn_sched_barrier(0);
#pragma unroll
      for (int ks = 0; ks < NKS; ++ks) {
        if (ks == 0) { s0 = MFMA32(kf[0], qf[0], negm); s1 = MFMA32(kf[1], qf[0], negm); }
        else { s0 = MFMA32(kf[2 * ks], qf[ks], s0); s1 = MFMA32(kf[2 * ks + 1], qf[ks], s1); }
      }
      bf16x8 vf0[4], vf1[4];
#pragma unroll
      for (int s4 = 0; s4 < 4; ++s4) { vf0[s4] = *(const bf16x8*)(Vs + l31 * 144 + s4 * 32 + hh * 16); vf1[s4] = *(const bf16x8*)(Vs + (32 + l31) * 144 + s4 * 32 + hh * 16); }
      __builtin_amdgcn_sched_barrier(0);
      if (NA && win) {
        const float* rpl = rpbs + (kr - qrow + 7) * 31 + (4 * hh - qc + 15);
        const int kb = 4 * hh - cs;
#pragma unroll
        for (int r = 0; r < 16; ++r) {
          const int c0 = (r & 3) + 8 * (r >> 2);
          s0[r] = ((unsigned)(kb + c0) < 16u) ? s0[r] + rpl[c0] : -INFINITY;
          s1[r] = ((unsigned)(kb + c0 + 32) < 16u) ? s1[r] + rpl[c0 + 32] : -INFINITY;
        }
      }
      float ma = fmaxf(fmaxf(s0[0], s0[1]), s1[0]), mb = fmaxf(fmaxf(s0[2], s0[3]), s1[1]);
      ma = fmaxf(fmaxf(ma, s1[2]), s1[3]);
#pragma unroll
      for (int r = 4; r < 16; r += 4) { ma = fmaxf(fmaxf(ma, s0[r]), s0[r + 1]); mb = fmaxf(fmaxf(mb, s0[r + 2]), s0[r + 3]); ma = fmaxf(fmaxf(ma, s1[r]), s1[r + 1]); mb = fmaxf(fmaxf(mb, s1[r + 2]), s1[r + 3]); }
      float mx = fmaxf(ma, mb);
      mx = xhalf_max(mx);
      if (first || __any(mx > ATT_THR)) {
        const float dl = first ? mx : fmaxf(mx, 0.f);
        const float al = first ? 1.0f : __builtin_amdgcn_exp2f(-dl);
        first = false;
        mrun += dl;
        lsum *= al;
#pragma unroll
        for (int r = 0; r < 16; ++r) { s0[r] -= dl; s1[r] -= dl; o0[r] *= al; o1[r] *= al; negm[r] = -mrun; }
      }
      f32x2_t ps2 = {0.f, 0.f};
#pragma unroll
      for (int r = 0; r < 16; ++r) { s0[r] = __builtin_amdgcn_exp2f(s0[r]); s1[r] = __builtin_amdgcn_exp2f(s1[r]); }
#pragma unroll
      for (int r = 0; r < 16; r += 2) { ps2 += (f32x2_t){s0[r], s0[r + 1]}; ps2 += (f32x2_t){s1[r], s1[r + 1]}; }
      lsum += ps2[0] + ps2[1];
      u32x4 pw[4];
#pragma unroll
      for (int j = 0; j < 4; ++j) { pw[0][j] = pk2(s0[2 * j], s0[2 * j + 1]); pw[1][j] = pk2(s0[8 + 2 * j], s0[8 + 2 * j + 1]); pw[2][j] = pk2(s1[2 * j], s1[2 * j + 1]); pw[3][j] = pk2(s1[8 + 2 * j], s1[8 + 2 * j + 1]); }
#pragma unroll
      for (int s4 = 0; s4 < 4; ++s4) {
        o0 = MFMA32(vf0[s4], as_bf16x8(pw[s4]), o0);
        o1 = MFMA32(vf1[s4], as_bf16x8(pw[s4]), o1);
      }
    }
    if (more) swrite(st ^ 1);
    __syncthreads();
  }
  const float lt = lsum + xhalf(lsum);
  const float inv = 1.0f / lt;
  bf16_t* orow = Ow + (size_t)l31 * NP;
  u32x2 zall[8];
#pragma unroll
  for (int q8 = 0; q8 < 8; ++q8) zall[q8] = *(const u32x2*)(orow + (q8 >> 2) * 32 + 8 * (q8 & 3) + 4 * hh);
#pragma unroll
  for (int dvb = 0; dvb < 2; ++dvb)
#pragma unroll
    for (int rg = 0; rg < 4; ++rg) {
      const int dv = dvb * 32 + 8 * rg + 4 * hh;
      const u32x2 zw = zall[dvb * 4 + rg];
      float z[4] = {__uint_as_float(zw[0] << 16), __uint_as_float(zw[0] & 0xffff0000u), __uint_as_float(zw[1] << 16), __uint_as_float(zw[1] & 0xffff0000u)};
      float ov[4];
#pragma unroll
      for (int j = 0; j < 4; ++j) { const float oo = (dvb == 0 ? o0[4 * rg + j] : o1[4 * rg + j]) * inv; ov[j] = oo * siluf_(z[j]); }
      u32x2 w; w[0] = pk2(ov[0], ov[1]); w[1] = pk2(ov[2], ov[3]);
      *(u32x2*)(orow + dv) = w;
    }
}


namespace pg8 {
#define PG8_LAS __attribute__((address_space(3)))
typedef unsigned short bf16_t;
typedef short bf16x8 __attribute__((ext_vector_type(8)));
typedef float f32x4 __attribute__((ext_vector_type(4)));
typedef unsigned u32x4 __attribute__((ext_vector_type(4)));
constexpr int BM = 256, BK = 64, HALF = 128, HTB = HALF * BK * 2  , STAGE_BYTES = 8 * HTB, NXCD = 8, WGM = 8;

__host__ __device__ __forceinline__ int lds_byte(int r, int c) { const int st = (r >> 4) * 2 + (c >> 5), rr = r & 15, cc = c & 31, ob = rr * 64 + cc * 2; return st * 1024 + (ob ^ (((ob >> 9) & 1) << 5)); }
__host__ __device__ __forceinline__ void stage_rc(int b, int& R, int& C) { const int st = b / 1024, sb = b % 1024, swz = sb ^ (((sb >> 9) & 1) << 5); R = (st >> 1) * 16 + swz / 64; C = (st & 1) * 32 + (swz % 64) / 2; }
__host__ __device__ __forceinline__ int perm32(int rho) { const int n = rho >> 4, i = rho & 15; return 8 * (i >> 2) + 4 * n + (i & 3); }

struct Unit { int pm, pn; };
struct Gemm { const bf16_t* A; const bf16_t* Bt; int M, N, K, lda, ldb; };

struct StaticOrder {
    int nM, nN, nwg, G, c; int skipctx = 0;
    __host__ __device__ void init(int M, int N, int G_, int c_) { nM = M / BM; nN = N / BM; nwg = nM * nN; G = G_; c = c_; }
    __host__ __device__ bool next(int i, Unit& u) const {
        const long L = (long)i * G + c; if (L >= nwg) return false;
        int wgid = (int)L; { const int q = nwg / NXCD, r = nwg % NXCD, xcd = wgid % NXCD, off = wgid / NXCD; wgid = (xcd < r ? xcd * (q + 1) : r * (q + 1) + (xcd - r) * q) + off; }
        const int nig = WGM * nN, gid = wgid / nig, fm = gid * WGM, gsz = (nM - fm) < WGM ? (nM - fm) : WGM;
        u.pm = fm + ((wgid % nig) % gsz); u.pn = (wgid % nig) / gsz; if (skipctx && u.pm >= 32) u.pm += 1; return true;
    }
    __device__ __forceinline__ void a_ready(const Unit&) const {}
    __device__ __forceinline__ void done(const Unit&) const {}
};
__device__ __forceinline__ unsigned cvt_pk_bf16(float lo, float hi) { unsigned r; asm volatile("v_cvt_pk_bf16_f32 %0, %1, %2" : "=v"(r) : "v"(lo), "v"(hi)); return r; }
struct EpiStoreBf16 {
    static constexpr bool PERM = true, AFTER_DRAIN = false;
    bf16_t* O; int ldc; int sc_lo, sc_hi; float sc;
    __device__ __forceinline__ void operator()(const f32x4 (&acc)[2][2][4][2], const Unit& u, int wr, int wc, int fr, int fq) const {
        const int row0 = u.pm * BM + wr * 64 + fr, colt = u.pn * BM, col0 = colt + wc * 32 + 8 * fq;
        const float s = (colt >= sc_lo && colt < sc_hi) ? sc : ((colt >= 4096) ? -1.4426950408889634f : 1.0f);
#pragma unroll
        for (int ai = 0; ai < 2; ++ai)
#pragma unroll
            for (int m = 0; m < 4; ++m) { bf16_t* rowp = O + (size_t)(row0 + ai * HALF + m * 16) * ldc + col0;
#pragma unroll
                for (int bj = 0; bj < 2; ++bj) { const f32x4 v0 = acc[ai][bj][m][0] * s, v1 = acc[ai][bj][m][1] * s;
                    u32x4 w; w.x = cvt_pk_bf16(v0[0], v0[1]); w.y = cvt_pk_bf16(v0[2], v0[3]); w.z = cvt_pk_bf16(v1[0], v1[1]); w.w = cvt_pk_bf16(v1[2], v1[3]);
                    *(u32x4*)(rowp + bj * HALF) = w; } }
    }
};

struct EpiOutResid {
    static constexpr bool PERM = true, AFTER_DRAIN = false;
    float* X; const float* gate3;
    const float* xin; const float* cin;
    __device__ __forceinline__ void operator()(const f32x4 (&acc_)[2][2][4][2], const Unit& u, int wr, int wc, int fr, int fq) const {
        f32x4 (&acc)[2][2][4][2] = const_cast<f32x4 (&)[2][2][4][2]>(acc_);
        const int rowp = u.pm * BM, b = rowp / 8448, tb = rowp % 8448, vs = (tb < 8192) ? b : 2;
        const int row0 = rowp + wr * 64 + fr, col0 = u.pn * BM + wc * 32 + 8 * fq;
        const float* gp = gate3 + (size_t)vs * 3072 + col0;
#pragma unroll
        for (int bj = 0; bj < 2; ++bj) { const f32x4 g0 = *(const f32x4*)(gp + bj * HALF), g1 = *(const f32x4*)(gp + bj * HALF + 4);
#pragma unroll
            for (int ai = 0; ai < 2; ++ai)
#pragma unroll
                for (int m = 0; m < 4; ++m) { acc[ai][bj][m][0] = acc[ai][bj][m][0] * g0; acc[ai][bj][m][1] = acc[ai][bj][m][1] * g1; } }
        const float al = xin ? 1.6817928305074290f : 1.0f;
        const float* sbase = xin ? ((tb < 8192) ? xin + (size_t)(b * 8192 + tb + wr * 64 + fr) * 1024 : cin + (size_t)(b * 256 + (tb - 8192) + wr * 64 + fr) * 1024) : X + (size_t)row0 * 1024;
        float* dbase = X + (size_t)row0 * 1024;
#pragma unroll
        for (int bj = 0; bj < 2; ++bj)
#pragma unroll
            for (int ai = 0; ai < 2; ++ai)
#pragma unroll
                for (int mh = 0; mh < 2; ++mh) {
                    f32x4 x0[2], x1[2];
#pragma unroll
                    for (int mm = 0; mm < 2; ++mm) { const int ro = (ai * HALF + (2 * mh + mm) * 16) * 1024 + col0 + bj * HALF; x0[mm] = *(const f32x4*)(sbase + ro); x1[mm] = *(const f32x4*)(sbase + ro + 4); }
#pragma unroll
                    for (int mm = 0; mm < 2; ++mm) { const int m = 2 * mh + mm; const int ro = (ai * HALF + m * 16) * 1024 + col0 + bj * HALF;
                        *(f32x4*)(dbase + ro) = x0[mm] * al + acc[ai][bj][m][0]; *(f32x4*)(dbase + ro + 4) = x1[mm] * al + acc[ai][bj][m][1]; } }
    }
};

struct EpiOutPart {
    static constexpr bool PERM = true, AFTER_DRAIN = false;
    float* XPs; const float* gate;
    __device__ __forceinline__ void operator()(const f32x4 (&acc)[2][2][4][2], const Unit& u, int wr, int wc, int fr, int fq) const {
        const int row0 = (u.pm == 32 ? 0 : 256) + wr * 64 + fr, col0 = u.pn * BM + wc * 32 + 8 * fq;
#pragma unroll
        for (int bj = 0; bj < 2; ++bj) { const f32x4 g0 = *(const f32x4*)(gate + col0 + bj * HALF), g1 = *(const f32x4*)(gate + col0 + bj * HALF + 4);
#pragma unroll
            for (int ai = 0; ai < 2; ++ai)
#pragma unroll
                for (int m = 0; m < 4; ++m) { float* xp = XPs + (size_t)(row0 + ai * HALF + m * 16) * 1024 + col0 + bj * HALF;
                    *(f32x4*)xp = g0 * acc[ai][bj][m][0]; *(f32x4*)(xp + 4) = g1 * acc[ai][bj][m][1]; } }
    }
};
struct CtxOrder {
    int j;
    __device__ __forceinline__ bool next(int i, Unit& u) const { if (i != 0 || j < 0 || j >= 8) return false; u.pm = (j < 4) ? 32 : 65; u.pn = j & 3; return true; }
    __device__ __forceinline__ void a_ready(const Unit&) const {}
    __device__ __forceinline__ void done(const Unit&) const {}
};
__device__ __forceinline__ float pg_sig(float x) { return __builtin_amdgcn_rcpf(1.0f + __expf(-x)); }
__device__ __forceinline__ void pg_unpack8(const u32x4 w, float* f) { f[0] = __uint_as_float(w.x << 16); f[1] = __uint_as_float(w.x & 0xffff0000u); f[2] = __uint_as_float(w.y << 16); f[3] = __uint_as_float(w.y & 0xffff0000u);
    f[4] = __uint_as_float(w.z << 16); f[5] = __uint_as_float(w.z & 0xffff0000u); f[6] = __uint_as_float(w.w << 16); f[7] = __uint_as_float(w.w & 0xffff0000u); }
struct EpiGlu {
    static constexpr bool PERM = true, AFTER_DRAIN = false;
    bf16_t* Pb; int ldp, ycol, zcol; const float* bias;
    __device__ __forceinline__ void operator()(const f32x4 (&acc)[2][2][4][2], const Unit& u, int wr, int wc, int fr, int fq) const {
        const int row0 = u.pm * BM + wr * 64 + fr, col0 = u.pn * BM + wc * 32 + 8 * fq;
#pragma unroll
        for (int bj = 0; bj < 2; ++bj) { const f32x4 b0 = *(const f32x4*)(bias + col0 + bj * HALF), b1 = *(const f32x4*)(bias + col0 + bj * HALF + 4);
#pragma unroll
            for (int ai = 0; ai < 2; ++ai)
#pragma unroll
                for (int mh = 0; mh < 2; ++mh) {
                    u32x4 yw[2], zw[2];
#pragma unroll
                    for (int mm = 0; mm < 2; ++mm) { const bf16_t* pr = Pb + (size_t)(row0 + ai * HALF + (2 * mh + mm) * 16) * ldp + col0 + bj * HALF; yw[mm] = *(const u32x4*)(pr + ycol); zw[mm] = *(const u32x4*)(pr + zcol); }
#pragma unroll
                    for (int mm = 0; mm < 2; ++mm) { const int m = 2 * mh + mm; bf16_t* pr = Pb + (size_t)(row0 + ai * HALF + m * 16) * ldp + col0 + bj * HALF;
                        float y[8], z[8]; pg_unpack8(yw[mm], y); pg_unpack8(zw[mm], z);
                        const f32x4 a0 = acc[ai][bj][m][0] + b0, a1 = acc[ai][bj][m][1] + b1; float o[8];
#pragma unroll
                        for (int j = 0; j < 4; ++j) { o[j] = y[j] * pg_sig(a0[j]) * (z[j] * pg_sig(z[j])); o[4 + j] = y[4 + j] * pg_sig(a1[j]) * (z[4 + j] * pg_sig(z[4 + j])); }
                        u32x4 w; w.x = cvt_pk_bf16(o[0], o[1]); w.y = cvt_pk_bf16(o[2], o[3]); w.z = cvt_pk_bf16(o[4], o[5]); w.w = cvt_pk_bf16(o[6], o[7]);
                        *(u32x4*)(pr + zcol) = w; } } }
    }
};
struct EpiBranch {
    static constexpr bool PERM = true, AFTER_DRAIN = false;
    bf16_t* Mo; const bf16_t* G; int ldg; int first; const bf16_t* M2;
    __device__ __forceinline__ void operator()(const f32x4 (&acc)[2][2][4][2], const Unit& u, int wr, int wc, int fr, int fq) const {
        const int row0 = u.pm * BM + wr * 64 + fr, col0 = u.pn * BM + wc * 32 + 8 * fq;
#pragma unroll
        for (int ai = 0; ai < 2; ++ai)
#pragma unroll
            for (int bj = 0; bj < 2; ++bj)
#pragma unroll
                for (int mh = 0; mh < 2; ++mh) {
                    u32x4 gw[2], mw[2], m2w[2];
#pragma unroll
                    for (int mm = 0; mm < 2; ++mm) { const size_t r = (size_t)(row0 + ai * HALF + (2 * mh + mm) * 16);
                        gw[mm] = *(const u32x4*)(G + r * ldg + col0 + bj * HALF);
                        mw[mm] = first ? (u32x4){0u, 0u, 0u, 0u} : *(const u32x4*)(Mo + r * 1024 + col0 + bj * HALF);
                        m2w[mm] = M2 ? *(const u32x4*)(M2 + r * 1024 + col0 + bj * HALF) : (u32x4){0u, 0u, 0u, 0u}; }
#pragma unroll
                    for (int mm = 0; mm < 2; ++mm) { const int m = 2 * mh + mm; const size_t r = (size_t)(row0 + ai * HALF + m * 16);
                        float gt[8], o[8], o2[8]; pg_unpack8(gw[mm], gt); pg_unpack8(mw[mm], o); pg_unpack8(m2w[mm], o2);
#pragma unroll
                        for (int j = 0; j < 4; ++j) { o[j] += o2[j] + __builtin_amdgcn_rcpf(1.0f + __builtin_amdgcn_exp2f(gt[j])) * acc[ai][bj][m][0][j]; o[4 + j] += o2[4 + j] + __builtin_amdgcn_rcpf(1.0f + __builtin_amdgcn_exp2f(gt[4 + j])) * acc[ai][bj][m][1][j]; }
                        u32x4 w; w.x = cvt_pk_bf16(o[0], o[1]); w.y = cvt_pk_bf16(o[2], o[3]); w.z = cvt_pk_bf16(o[4], o[5]); w.w = cvt_pk_bf16(o[6], o[7]);
                        *(u32x4*)(Mo + r * 1024 + col0 + bj * HALF) = w; } }
    }
};

template <class Epi, class Sched, bool ALIGN_EPI = false, bool SP2 = false>
__device__ __forceinline__ void gemm_phase(PG8_LAS unsigned char* lds, const Gemm g, const Sched& S, const Epi& E) {
    const int tid = otid(), wid = __builtin_amdgcn_readfirstlane(tid >> 6), lane = tid & 63, wr = wid >> 2, wc = wid & 3, fr = lane & 15, fq = lane >> 4;
    const int K = g.K, nt = K / BK;
    unsigned voffA[2], voffB[2];
#pragma unroll
    for (int i = 0; i < 2; ++i) { int R, C; stage_rc(tid * 16 + i * 8192, R, C); const int Rb = Epi::PERM ? ((R & ~31) + perm32(R & 31)) : R;
        voffA[i] = (unsigned)(R * g.lda + C) * 2u; voffB[i] = (unsigned)(Rb * g.ldb + C) * 2u; }
    const size_t kstep = (size_t)(BK * 2);
    const size_t hstep = (size_t)HALF * g.ldb * 2;
    const size_t tstep = 2 * hstep;
    const size_t hstepA = (size_t)HALF * g.lda * 2, tstepA = 2 * hstepA;
    const unsigned ldsw = (unsigned)wid * 1024u;
    const int aoff = lds_byte(wr * 64 + fr, fq * 8), boff = lds_byte(wc * 32 + fr, fq * 8);
#define PG8_SA(b, h) (((b) * 2 + (h)) * HTB)
#define PG8_SB(b, h) ((4 + (b) * 2 + (h)) * HTB)
#define PG8_STAGE(bufoff, gbase, voff) do { _Pragma("unroll") for (int _i = 0; _i < 2; ++_i) \
        __builtin_amdgcn_global_load_lds((const unsigned*)((const char*)(gbase) + (voff)[_i]), (PG8_LAS unsigned*)(lds + (bufoff) + ldsw + _i * 8192), 16, 0, 0); } while (0)
#define PG8_LDA(dst, b, h) do { _Pragma("unroll") for (int m = 0; m < 4; ++m) _Pragma("unroll") for (int k = 0; k < 2; ++k) dst[m][k] = *(const PG8_LAS bf16x8*)(lds + PG8_SA(b, h) + aoff + m * 2048 + k * 1024); } while (0)
#define PG8_LDB(dst, b, h) do { _Pragma("unroll") for (int n = 0; n < 2; ++n) _Pragma("unroll") for (int k = 0; k < 2; ++k) dst[n][k] = *(const PG8_LAS bf16x8*)(lds + PG8_SB(b, h) + boff + n * 2048 + k * 1024); } while (0)
#define PG8_MMA(ai, bj, At, Bt) do { __builtin_amdgcn_s_setprio(1); _Pragma("unroll") for (int m = 0; m < 4; ++m) _Pragma("unroll") for (int n = 0; n < 2; ++n) _Pragma("unroll") for (int k = 0; k < 2; ++k) \
        acc[ai][bj][m][n] = __builtin_amdgcn_mfma_f32_16x16x32_bf16(Bt[n][k], At[m][k], acc[ai][bj][m][n], 0, 0, 0); __builtin_amdgcn_s_setprio(0); } while (0)
#define PG8_WAIT_V(n) asm volatile("s_waitcnt vmcnt(" #n ")" ::: "memory")
#define PG8_WAIT_L(n) asm volatile("s_waitcnt lgkmcnt(" #n ")" ::: "memory")
#define PG8_BAR __builtin_amdgcn_s_barrier()
#define PG8_SCHED __builtin_amdgcn_sched_barrier(0)
    Unit cur, nxt; nxt.pm = 0; nxt.pn = 0; int ui = 0;
    if (!S.next(0, cur)) return;
    f32x4 acc[2][2][4][2];
#pragma unroll
    for (int a = 0; a < 2; ++a)
#pragma unroll
        for (int b = 0; b < 2; ++b)
#pragma unroll
            for (int m = 0; m < 4; ++m)
#pragma unroll
                for (int n = 0; n < 2; ++n) acc[a][b][m][n] = (f32x4){0.f, 0.f, 0.f, 0.f};
    bf16x8 At[4][2], B0[2][2], B1[2][2];
    const char* cA = (const char*)g.A + (size_t)cur.pm * tstepA; const char* cB = (const char*)g.Bt + (size_t)cur.pn * tstep;
    S.a_ready(cur);
    if constexpr (SP2) {
        PG8_STAGE(PG8_SB(0, 0), cB, voffB); PG8_STAGE(PG8_SB(0, 1), cB + hstep, voffB); PG8_STAGE(PG8_SA(0, 0), cA, voffA); PG8_STAGE(PG8_SA(0, 1), cA + hstepA, voffA);
        if (wr == 1) PG8_BAR;
        PG8_WAIT_V(2); PG8_BAR;
        PG8_STAGE(PG8_SB(1, 0), cB + kstep, voffB); PG8_STAGE(PG8_SA(1, 0), cA + kstep, voffA); PG8_STAGE(PG8_SB(1, 1), cB + hstep + kstep, voffB);
        PG8_WAIT_V(6); PG8_BAR;
    } else {
        PG8_STAGE(PG8_SB(0, 0), cB, voffB); PG8_STAGE(PG8_SA(0, 0), cA, voffA); PG8_STAGE(PG8_SB(0, 1), cB + hstep, voffB); PG8_STAGE(PG8_SA(0, 1), cA + hstepA, voffA);
        if (wr == 1) PG8_BAR;
        PG8_WAIT_V(4); PG8_BAR;
        PG8_STAGE(PG8_SB(1, 0), cB + kstep, voffB); PG8_STAGE(PG8_SA(1, 0), cA + kstep, voffA); PG8_STAGE(PG8_SB(1, 1), cB + hstep + kstep, voffB);
        PG8_WAIT_V(6); PG8_BAR;
    }
    for (;;) {
        const bool has_next = S.next(ui + 1, nxt);
        const char* nA = has_next ? (const char*)g.A + (size_t)nxt.pm * tstepA : cA; const char* nB = has_next ? (const char*)g.Bt + (size_t)nxt.pn * tstep : cB;
        for (int t = 0; t < nt; t += 2) {
            const bool last = (t == nt - 2);
            const char* a1 = cA + (size_t)(t + 1) * kstep;
            const char* a2 = last ? nA : cA + (size_t)(t + 2) * kstep; const char* b2 = last ? nB : cB + (size_t)(t + 2) * kstep;
            const char* a3 = a2 + kstep; const char* b3 = b2 + kstep;
            if (last && has_next) S.a_ready(nxt);
            if constexpr (SP2) {
            PG8_LDB(B0, 0, 0); PG8_LDB(B1, 0, 1); PG8_SCHED; PG8_LDA(At, 0, 0); PG8_STAGE(PG8_SA(1, 1), a1 + hstepA, voffA);
            PG8_WAIT_V(8); PG8_WAIT_L(0); PG8_BAR; PG8_MMA(0, 0, At, B0); PG8_MMA(0, 1, At, B1); PG8_BAR; PG8_SCHED;
            PG8_LDA(At, 0, 1); PG8_STAGE(PG8_SB(0, 0), b2, voffB); PG8_STAGE(PG8_SB(0, 1), b2 + hstep, voffB); PG8_STAGE(PG8_SA(0, 0), a2, voffA);
            PG8_WAIT_V(8); PG8_WAIT_L(0); PG8_BAR; PG8_MMA(1, 0, At, B0); PG8_MMA(1, 1, At, B1); PG8_BAR; PG8_SCHED;
            PG8_LDB(B0, 1, 0); PG8_LDB(B1, 1, 1); PG8_SCHED; PG8_LDA(At, 1, 0); PG8_STAGE(PG8_SA(0, 1), a2 + hstepA, voffA);
            PG8_WAIT_V(8); PG8_WAIT_L(0); PG8_BAR; PG8_MMA(0, 0, At, B0); PG8_MMA(0, 1, At, B1); PG8_BAR; PG8_SCHED;
            PG8_LDA(At, 1, 1); PG8_STAGE(PG8_SB(1, 0), b3, voffB); PG8_STAGE(PG8_SB(1, 1), b3 + hstep, voffB); PG8_STAGE(PG8_SA(1, 0), a3, voffA);
            PG8_WAIT_V(8); PG8_WAIT_L(0); PG8_BAR; PG8_MMA(1, 0, At, B0); PG8_MMA(1, 1, At, B1); PG8_BAR; PG8_SCHED;
            } else {
            PG8_LDB(B0, 0, 0); PG8_SCHED; PG8_LDA(At, 0, 0); PG8_STAGE(PG8_SA(1, 1), a1 + hstepA, voffA);
            PG8_WAIT_L(8); PG8_BAR; PG8_WAIT_L(0); PG8_MMA(0, 0, At, B0); PG8_BAR; PG8_SCHED;
            PG8_LDB(B1, 0, 1); PG8_STAGE(PG8_SB(0, 0), b2, voffB);
            PG8_BAR; PG8_WAIT_L(0); PG8_MMA(0, 1, At, B1); PG8_BAR;
            PG8_LDA(At, 0, 1); PG8_STAGE(PG8_SA(0, 0), a2, voffA);
            PG8_BAR; PG8_WAIT_L(0); PG8_MMA(1, 0, At, B0); PG8_BAR; PG8_SCHED;
            PG8_STAGE(PG8_SB(0, 1), b2 + hstep, voffB);
            PG8_WAIT_V(6); PG8_BAR; PG8_MMA(1, 1, At, B1); PG8_BAR;
            PG8_LDB(B0, 1, 0); PG8_SCHED; PG8_LDA(At, 1, 0); PG8_STAGE(PG8_SA(0, 1), a2 + hstepA, voffA);
            PG8_WAIT_L(8); PG8_BAR; PG8_WAIT_L(0); PG8_MMA(0, 0, At, B0); PG8_BAR; PG8_SCHED;
            PG8_LDB(B1, 1, 1); PG8_STAGE(PG8_SB(1, 0), b3, voffB);
            PG8_BAR; PG8_WAIT_L(0); PG8_MMA(0, 1, At, B1); PG8_BAR;
            PG8_LDA(At, 1, 1); PG8_STAGE(PG8_SA(1, 0), a3, voffA);
            PG8_BAR; PG8_WAIT_L(0); PG8_MMA(1, 0, At, B0); PG8_BAR; PG8_SCHED;
            PG8_STAGE(PG8_SB(1, 1), b3 + hstep, voffB);
            PG8_WAIT_V(6); PG8_BAR; PG8_MMA(1, 1, At, B1); PG8_BAR;
            }
        }
        if constexpr (ALIGN_EPI) { if (wr == 0) PG8_BAR; }
        if constexpr (!Epi::AFTER_DRAIN) { E(acc, cur, wr, wc, fr, fq); S.done(cur); }
        if (!has_next) break;
#pragma unroll
        for (int a = 0; a < 2; ++a)
#pragma unroll
            for (int b = 0; b < 2; ++b)
#pragma unroll
                for (int m = 0; m < 4; ++m)
#pragma unroll
                    for (int n = 0; n < 2; ++n) acc[a][b][m][n] = (f32x4){0.f, 0.f, 0.f, 0.f};
        cur = nxt; cA = nA; cB = nB; ++ui;
        if constexpr (ALIGN_EPI) { if (wr == 1) PG8_BAR; }
    }
    PG8_WAIT_V(0);
    if constexpr (!ALIGN_EPI) { if (wr == 0) PG8_BAR; }
    PG8_BAR;
    if constexpr (Epi::AFTER_DRAIN) { E.fused(acc, cur, wr, wc, fr, fq, lds, wid, lane); S.done(cur); }
#undef PG8_SA
#undef PG8_SB
#undef PG8_STAGE
#undef PG8_LDA
#undef PG8_LDB
#undef PG8_MMA
#undef PG8_WAIT_V
#undef PG8_WAIT_L
#undef PG8_BAR
#undef PG8_SCHED
}
}

#define LAS __attribute__((address_space(3)))
#define XB_TMO      128
#define XB_XCNT(j)  (256  + 64 * (j))
#define XB_XSUB(j)  (1280 + 64 * (j))
#define XB_XGEN(j)  (2304 + 64 * (j))
#define XB_TOP      3328
#define XB_TOPGEN   3392
#define XCD_BAR_WORDS 3456
#define XB_SPIN_CAP (1u << 18)
__device__ __forceinline__ unsigned xb_ld(unsigned* p)              { return __hip_atomic_load(p, __ATOMIC_RELAXED, __HIP_MEMORY_SCOPE_AGENT); }
__device__ __forceinline__ unsigned xb_add(unsigned* p, unsigned v) { return __hip_atomic_fetch_add(p, v, __ATOMIC_RELAXED, __HIP_MEMORY_SCOPE_AGENT); }
__device__ __forceinline__ unsigned xb_xcc_id() { return (unsigned)__builtin_amdgcn_s_getreg((3 << 11) | 20) & 0xFu; }
#define XB_SPIN(cond, bar) do { unsigned _sp = 0; while (cond) { __builtin_amdgcn_s_sleep(1); \
    if ((++_sp & 255u) == 0u) { if (xb_ld(&(bar)[XB_TMO])) break; if (_sp > XB_SPIN_CAP) { atomicAdd(&(bar)[XB_TMO], 1u); break; } } } } while (0)
struct XcdBarrier { unsigned* bar; unsigned x; volatile LAS unsigned* st; };
__device__ __forceinline__ XcdBarrier xcd_barrier_post(unsigned* bar, volatile LAS unsigned* st) {
    XcdBarrier b; b.bar = bar; b.x = xb_xcc_id(); b.st = st;
    if (threadIdx.x == 0) (void)xb_add(&bar[XB_XCNT(b.x)], 1u);
    return b;
}
__device__ __forceinline__ void xcd_barrier_complete(unsigned* bar, unsigned x, unsigned& nloc, unsigned& nx) {
    const unsigned G = gridDim.x * gridDim.y * gridDim.z;
    unsigned sum, cnt, mine, sp = 0u;
    for (;;) {
        sum = 0u; cnt = 0u; mine = 0u;
#pragma unroll
        for (unsigned j = 0; j < 16; ++j) { const unsigned c = xb_ld(&bar[XB_XCNT(j)]); sum += c; cnt += (c > 0u) ? 1u : 0u; mine = (j == x) ? c : mine; }
        if (sum == G) break;
        __builtin_amdgcn_s_sleep(1);
        if ((++sp & 255u) == 0u) { if (xb_ld(&bar[XB_TMO])) break; if (sp > XB_SPIN_CAP) { atomicAdd(&bar[XB_TMO], 1u); break; } }
    }
    nloc = mine > 0u ? mine : 1u; nx = cnt > 0u ? cnt : 1u;
}
__device__ __forceinline__ void xcd_barrier(const XcdBarrier& b) {
    asm volatile("s_waitcnt vmcnt(0)" ::: "memory");
    __syncthreads();
    if (threadIdx.x == 0) {
        unsigned* bar = b.bar; asm volatile("" : "+s"(bar));
        unsigned bx = b.x; asm volatile("" : "+s"(bx));
        __builtin_amdgcn_s_waitcnt(0);
        unsigned nloc = b.st[0], nx = b.st[1];
        if (nloc == 0u) { xcd_barrier_complete(bar, bx, nloc, nx); b.st[0] = nloc; b.st[1] = nx; }
        const unsigned old = xb_add(&bar[XB_XSUB(bx)], 1u);
        const unsigned gen = old / nloc;
        if (old + 1u == (gen + 1u) * nloc) {
            __builtin_amdgcn_fence(__ATOMIC_RELEASE, "agent");
            asm volatile("s_waitcnt vmcnt(0)" ::: "memory");
            const unsigned og = xb_add(&bar[XB_TOP], 1u);
            const unsigned tg = og / nx;
            if (og + 1u == (tg + 1u) * nx) xb_add(&bar[XB_TOPGEN], 1u);
            else XB_SPIN(xb_ld(&bar[XB_TOPGEN]) == tg, bar);
            __builtin_amdgcn_fence(__ATOMIC_ACQUIRE, "agent");
            xb_add(&bar[XB_XGEN(bx)], 1u);
            asm volatile("s_waitcnt vmcnt(0)" ::: "memory");
        } else {
            XB_SPIN(xb_ld(&bar[XB_XGEN(bx)]) == gen, bar);
            __builtin_amdgcn_fence(__ATOMIC_ACQUIRE, "agent");
            asm volatile("s_waitcnt vmcnt(0)" ::: "memory");
        }
    }
    __syncthreads();
}

__global__ void __launch_bounds__(512) hybrid_fwd(Params p) {
  extern __shared__ __attribute__((aligned(16))) char lds[];
  cg::grid_group grid = cg::this_grid();
  const int blk = blockIdx.x, nblk = gridDim.x;
  if (threadIdx.x == 0) { ((volatile LAS unsigned*)(lds + LDS_XB))[0] = 0u; ((volatile LAS unsigned*)(lds + LDS_XB))[1] = 0u; }
  if (blk == 0) { unsigned* bw = (unsigned*)(p.ws + WS_BAR); for (int i = threadIdx.x; i < XCD_BAR_WORDS; i += 512) bw[i] = 0u; }
  __syncthreads();
#define PHASE_VARS \
  const int tid = otid(), lane = tid & 63, wid = tid >> 6; \
  const int gtid = blk * 512 + tid, gthreads = nblk * 512, gwave = blk * 8 + wid, nwave = nblk * 8; \
  unsigned char* ws = opq(p.ws); \
  float* MOD = (float*)(ws + WS_MOD); float* X = (float*)(ws + WS_X); bf16_t* H = (bf16_t*)(ws + WS_H); bf16_t* P = (bf16_t*)(ws + WS_P); \
  bf16_t* KB = (bf16_t*)(ws + WS_K); bf16_t* VMT = (bf16_t*)(ws + WS_VMT); bf16_t* VNT = (bf16_t*)(ws + WS_VNT); \
  (void)lane; (void)gtid; (void)gthreads; (void)gwave; (void)nwave; (void)MOD; (void)X; (void)H; (void)P; (void)KB; (void)VMT; (void)VNT;

  {
    PHASE_VARS
    float* sv = (float*)lds;
    float* red = (float*)lds + 3072;
    for (int i = tid; i < 3072; i += 512) { const int v = i >> 10, k = i & 1023; const float c = (v < 2) ? p.in[1][v * 1024 + k] : p.in[3][k]; sv[i] = siluf_(c); }
    __syncthreads();
    for (int it = blk; it < DEPTH * 48; it += nblk) {
      const int l = it / 48, cc = it % 48, col = cc * 64 + lane, ks = wid;
      const float* W = p.in[4] + (size_t)l * 1024 * 3072 + col;
      float a0 = 0.f, a1 = 0.f, a2 = 0.f;
#pragma unroll 16
      for (int k = ks * 128; k < ks * 128 + 128; ++k) { const float w = W[(size_t)k * 3072]; a0 += sv[k] * w; a1 += sv[1024 + k] * w; a2 += sv[2048 + k] * w; }
      red[(ks * 3 + 0) * 64 + lane] = a0; red[(ks * 3 + 1) * 64 + lane] = a1; red[(ks * 3 + 2) * 64 + lane] = a2;
      __syncthreads();
      if (tid < 192) { const int v = tid >> 6, c = tid & 63; float s = 0.f; for (int k = 0; k < 8; ++k) s += red[(k * 3 + v) * 64 + c]; MOD[(size_t)(l * 3 + v) * 3072 + cc * 64 + c] = s + p.in[5][l * 3072 + cc * 64 + c]; }
      __syncthreads();
    }
    convert_layer_weights(p, 0, gtid, gthreads, 2);
    for (int idx = gtid; idx < DEPTH * 2 * 32 * 64; idx += gthreads) {
      const int pp = idx & 63, dg = idx >> 6;
      const double dt = exp((double)p.in[9][dg]);
      const double lr = (double)p.in[7][idx], li = (double)p.in[8][idx];
      const double mag = exp(lr * dt), ar = mag * cos(li * dt), ai = mag * sin(li * dt);
      double pr = ar, pi = ai;
      for (int s = 0; s < 6; ++s) { const double nr = pr * pr - pi * pi, ni = 2.0 * pr * pi; pr = nr; pi = ni; }
      float* sa = (float*)(ws + WS_SA) + (size_t)idx * 4;
      sa[0] = (float)ar; sa[1] = (float)ai; sa[2] = (float)pr; sa[3] = (float)pi;
      const double nr = ar - 1.0, den = lr * lr + li * li;
      const double fr = (nr * lr + ai * li) / den, fi = (ai * lr - nr * li) / den;
      bf16_t* bb = (bf16_t*)(ws + WS_BBT) + (size_t)dg * 128 * 16;
      const float* bre = p.in[10] + (size_t)idx * 16; const float* bim = p.in[11] + (size_t)idx * 16;
      for (int i = 0; i < 16; ++i) {
        const double br = bre[i], bi = bim[i];
        bb[(size_t)pp * 16 + i] = (bf16_t)f2bf((float)(fr * br - fi * bi));
        bb[(size_t)(64 + pp) * 16 + i] = (bf16_t)f2bf((float)(fr * bi + fi * br));
      }
    }
    for (int idx = gtid; idx < DEPTH * 2 * 32 * 32 * 128; idx += gthreads) {
      const int pq = idx & 127, i = (idx >> 7) & 31, dg = idx >> 12;
      float v = 0.f;
      if (i < 16) { const size_t ci = ((size_t)dg * 16 + i) * 64 + (pq >> 1); v = (pq & 1) ? -p.in[13][ci] : p.in[12][ci]; }
      ((bf16_t*)(ws + WS_CCT))[idx] = (bf16_t)f2bf(v);
    }
    for (int idx = gtid; idx < 128 * 8; idx += gthreads) {
      const int pos = idx >> 3, i = idx & 7;
      const double inv = pow(10000.0, -(double)i / 8.0), ang = (double)pos * inv;
      float* rt = (float*)(ws + WS_ROPE) + idx * 2; rt[0] = (float)cos(ang); rt[1] = (float)sin(ang);
    }
  }
  grid.sync();
  const XcdBarrier xb = xcd_barrier_post((unsigned*)(p.ws + WS_BAR), (volatile LAS unsigned*)(lds + LDS_XB));
  {
  PHASE_VARS
  for (int n = gwave; n < NTOK; n += nwave) {
    const int b = n / TB, t = n % TB, vs = (t < SEQ) ? b : 2;
    const float* md = MOD + (size_t)vs * 3072;
    f32x4 v[4];
    const float* xin = (t < SEQ) ? p.in[0] + (size_t)(b * SEQ + t) * 1024 : p.in[2] + (size_t)(b * CTX + (t - SEQ)) * 1024;
#pragma unroll
    for (int i = 0; i < 4; ++i) v[i] = *(const f32x4*)(xin + lane * 4 + 256 * i);
    wave_ln(v);
#pragma unroll
    for (int i = 0; i < 4; ++i) {
      const int c = lane * 4 + 256 * i;
      const f32x4 sh = *(const f32x4*)(md + c), sc = *(const f32x4*)(md + 1024 + c);
      const f32x4 h = v[i] * (sc + 1.0f) + sh;
      u32x2 w; w[0] = pk2(h[0], h[1]); w[1] = pk2(h[2], h[3]);
      *(u32x2*)(H + (size_t)n * 1024 + c) = w;
    }
  }
  }
  xcd_barrier(xb);

  for (int l = 0; l < DEPTH; ++l) {
    const bool need_ctx = (l < DEPTH - 1);
    {
      PHASE_VARS
      pg8::Gemm g{H, (const bf16_t*)(ws + WS_WIN), NTOK, NP, 1024, 1024, 1024};
      pg8::StaticOrder S; S.init(NTOK, NP, nblk, blk);
      pg8::EpiStoreBf16 E{P, NP, C_QN, C_KN, NA_QS};
      pg8::gemm_phase<pg8::EpiStoreBf16, pg8::StaticOrder, true, true>((PG8_LAS unsigned char*)lds, g, S, E);
    }
    xcd_barrier(xb);
    {
      PHASE_VARS
      bf16_t* Q = H;
      float* rstd = (float*)(lds + LDS_RSTD);
      const float* ROPE = (const float*)(ws + WS_ROPE);
      float* ropes = (float*)(lds + 143360);
      for (int i = tid; i < 128 * 16; i += 512) ropes[i] = ROPE[i];
      __syncthreads();
      for (int it = blk; it < 66 * 14; it += nblk) {
        const int tm = it / 14, tj = it % 14;
        const bool isq = tj < 6; const int tn = isq ? tj : tj - 6;
        const int row0 = tm * 256, Kd = isq ? 256 : 128, acol = isq ? C_CQ : C_CKV;
        const bf16_t* A = P + (size_t)row0 * NP + acol;
        {
          const int r = tid >> 1, hf = tid & 1; const bf16_t* ap = A + (size_t)r * NP + hf * (Kd >> 1);
          float s = 0.f;
          for (int c = 0; c < (Kd >> 1); c += 8) { float f[8]; unpack8(*(const u32x4*)(ap + c), f);
#pragma unroll
            for (int j = 0; j < 8; ++j) s += f[j] * f[j]; }
          s += __shfl_xor(s, 1);
          if (hf == 0) rstd[r] = 1.0f / sqrtf(s / (float)Kd + 1e-6f);
        }
        f32x16 acc[2][2]; zero_acc(acc);
        const bf16_t* Bt = isq ? (const bf16_t*)(ws + WS_WUQ) + (size_t)tn * 128 * 256 : (const bf16_t*)(ws + WS_WUKV) + (size_t)tn * 128 * 128;
        gemm_mainloop(lds, A, NP, Bt, Kd, Kd, acc);
        stage_acc(lds, acc);
        const int b = row0 / TB, tb = row0 % TB; const bool lat = tb < SEQ;
        if (isq) {
#pragma unroll
          for (int i = 0; i < 8; ++i) {
            int row, col; float v[8]; read_chunk(lds, i, row, col, v);
            const int gc = tn * 128 + col, j96 = gc % 96;
            const float rs = rstd[row] * MLA_QS;
            if (j96 >= 64 && lat) {
              const int jj = j96 - 64, axis = jj >> 4, second = (jj >> 3) & 1;
              const int t = tb + row, pos = axis == 0 ? (t >> 6) : (t & 63);
              const float* st = (const float*)lds + row * 132 + (second ? col - 8 : col + 8);
              const float* rt = ropes + pos * 16;
#pragma unroll
              for (int j = 0; j < 8; ++j) {
                const float cs_ = rt[2 * j], sn = rt[2 * j + 1], other = st[j];
                v[j] = second ? (other * sn + v[j] * cs_) : (v[j] * cs_ - other * sn);
              }
            }
#pragma unroll
            for (int j = 0; j < 8; ++j) v[j] *= rs;
            *(u32x4*)(Q + (size_t)(row0 + row) * 768 + gc) = pack8(v);
          }
        } else {
          const int h = tn;
#pragma unroll
          for (int i = 0; i < 4; ++i) {
            const int id = tid + 512 * i, row = id >> 3, col = (id & 7) * 8;
            const float* st = (const float*)lds + row * 132 + col; const float rs = rstd[row];
            float v[8];
#pragma unroll
            for (int j = 0; j < 8; ++j) v[j] = st[j] * rs;
            *(u32x4*)(KB + ((size_t)(row0 + row) * 8 + h) * 96 + col) = pack8(v);
          }
#pragma unroll
          for (int i = 0; i < 4; ++i) {
            const int id = tid + 512 * i, c = id & 63, rg = id >> 6;
            const float* st = (const float*)lds + (rg * 8) * 132 + 64 + c;
            float f[8];
#pragma unroll
            for (int j = 0; j < 8; ++j) f[j] = st[j * 132] * rstd[rg * 8 + j];
            *(u32x4*)(VMT + ((size_t)((b * 8 + h) * 64 + c)) * TB + tb + rg * 8) = pack8(f);
          }
        }
        __syncthreads();
      }
      for (int it = blk; it < NTOK / 64; it += nblk) {
        const int n0 = it * 64, b = n0 / TB, t0 = n0 % TB;
        bf16_t* tl = (bf16_t*)lds;
        u32x4 tv[8];
#pragma unroll
        for (int i = 0; i < 8; ++i) { const int id = tid + 512 * i, row = id >> 6, ch = id & 63; tv[i] = *(const u32x4*)(P + (size_t)(n0 + row) * NP + C_VN + ch * 8); }
#pragma unroll
        for (int i = 0; i < 8; ++i) { const int id = tid + 512 * i, row = id >> 6, ch = id & 63; *(u32x4*)(tl + row * 520 + ch * 8) = tv[i]; }
        __syncthreads();
#pragma unroll
        for (int rg = 0; rg < 8; ++rg) {
          u32x4 w;
#pragma unroll
          for (int j = 0; j < 4; ++j) w[j] = (unsigned)tl[(rg * 8 + 2 * j) * 520 + tid] | ((unsigned)tl[(rg * 8 + 2 * j + 1) * 520 + tid] << 16);
          *(u32x4*)(VNT + (size_t)(b * 512 + tid) * TB + t0 + rg * 8) = w;
        }
        __syncthreads();
      }
      for (int idx = gtid; idx < NTOK * 2; idx += gthreads) {
        const int n = idx >> 1, axis = idx & 1, t = n % TB;
        const bf16_t* kr = P + (size_t)n * NP + C_KR + axis * 16;
        float x1[8], x2[8], o1[8], o2[8];
        unpack8(*(const u32x4*)kr, x1); unpack8(*(const u32x4*)(kr + 8), x2);
        if (t < SEQ) {
          const int pos = axis == 0 ? (t >> 6) : (t & 63); const float* rt = ROPE + pos * 16;
#pragma unroll
          for (int j = 0; j < 8; ++j) { const float c = rt[2 * j], s = rt[2 * j + 1]; o1[j] = x1[j] * c - x2[j] * s; o2[j] = x1[j] * s + x2[j] * c; }
        } else {
#pragma unroll
          for (int j = 0; j < 8; ++j) { o1[j] = x1[j]; o2[j] = x2[j]; }
        }
        const u32x4 w1 = pack8(o1), w2 = pack8(o2);
#pragma unroll
        for (int h = 0; h < 8; ++h) { bf16_t* kp = KB + ((size_t)n * 8 + h) * 96 + 64 + axis * 16; *(u32x4*)kp = w1; *(u32x4*)(kp + 8) = w2; }
      }
      for (int it = nwave - 1 - gwave; it < 2 * 32 * NCH; it += nwave) { const int m = it % NCH, bg = it / NCH; s5_item(p, l, bg >> 5, bg & 31, m, 0, lds + wid * S5_WLDS); }
    }
    xcd_barrier(xb);
    {
      PHASE_VARS
      if (l + 1 < DEPTH && blk >= 16) convert_layer_weights(p, l + 1, (blk - 16) * 512 + tid, (nblk - 16) * 512, 0);
      if (gwave < 128) {
        const int d = gwave >> 6, g = gwave & 31;
        const f32x4 av = *(const f32x4*)((const float*)(ws + WS_SA) + ((size_t)((l * 2 + d) * 32 + g) * 64 + lane) * 4);
        float* Ed = (float*)(ws + WS_E) + (size_t)gwave * NCH * 128 + lane;
        float sr = 0.f, si = 0.f;
#pragma unroll 1
        for (int c0 = 0; c0 < NCH; c0 += 12) {
          float er[12], ei[12];
#pragma unroll
          for (int j = 0; j < 12; ++j) { er[j] = Ed[(size_t)(c0 + j) * 128]; ei[j] = Ed[(size_t)(c0 + j) * 128 + 64]; }
#pragma unroll
          for (int j = 0; j < 12; ++j) {
            Ed[(size_t)(c0 + j) * 128] = sr; Ed[(size_t)(c0 + j) * 128 + 64] = si;
            const float nr = av[2] * sr - av[3] * si + er[j], ni = av[2] * si + av[3] * sr + ei[j];
            sr = nr; si = ni;
          }
        }
      }
    }
    xcd_barrier(xb);
    {
#if EN_NA
      {
        PHASE_VARS
        float* rpbs = (float*)(lds + LDS_RPB);
#pragma unroll 1
        for (int j = 0; j < 3; ++j) {
          int bh, tok0, ntile, nwin, klo, qrow, qc0;
          if (j < 2) {
            const int rg = blk >> 3; if (rg >= 32) continue;
            bh = (blk & 7) + 8 * j;
            const int r0 = rg * 4;
            klo = min(max(r0 - 4, 0), 120); const int khi = min(max(r0 + 3 - 4, 0), 120) + 7; nwin = khi - klo + 1; ntile = nwin + 4;
            tok0 = (bh >> 3) * TB + r0 * 64 + 32 * wid; qrow = r0 + (wid >> 1); qc0 = 32 * (wid & 1);
          } else {
            if (!need_ctx || blk < 16 || blk >= 32) continue;
            bh = blk - 16; tok0 = (bh >> 3) * TB + SEQ + 32 * wid; ntile = 4; nwin = 0; klo = 0; qrow = 0; qc0 = 0;
          }
          const int b = bh >> 3, h = bh & 7;
          for (int i = tid; i < 465; i += 512) rpbs[i] = p.in[17][(size_t)(l * 8 + h) * 465 + i] * LOG2E;
          __syncthreads();
          attn_unit<64, true>(lds, P + (size_t)tok0 * NP + C_QN + h * 64, NP, P + (size_t)(b * TB) * NP + C_KN + h * 64, NP,
                              VNT + (size_t)((b * 8 + h) * 64) * TB, ntile, nwin, klo, qrow, qc0, P + (size_t)tok0 * NP + C_ZN + h * 64);
          __syncthreads();
        }
      }
#endif
#if EN_MLA
      {
        PHASE_VARS
        const bf16_t* Q = H;
#pragma unroll 1
        for (int j = 0; j < 3; ++j) {
          int bh, tok0, ntile, nwin;
          if (j < 2) {
            const int qb = blk >> 3; if (qb >= 32) continue;
            bh = (blk & 7) + 8 * j; tok0 = (bh >> 3) * TB + qb * 256 + 32 * wid; ntile = 132; nwin = 132;
          } else {
            if (!need_ctx || blk >= 16) continue;
            bh = blk; tok0 = (bh >> 3) * TB + SEQ + 32 * wid; ntile = 4; nwin = 0;
          }
          const int b = bh >> 3, h = bh & 7;
          attn_unit<96, false>(lds, Q + (size_t)tok0 * 768 + h * 96, 768, KB + (size_t)(b * TB) * 768 + h * 96, 768,
                               VMT + (size_t)((b * 8 + h) * 64) * TB, ntile, nwin, 0, 0, 0, P + (size_t)tok0 * NP + C_ZM + h * 64);
          __syncthreads();
        }
      }
#endif
#if EN_S5C
      {
        PHASE_VARS
        const int nch = need_ctx ? NCH : 128;
        for (int it = nwave - 1 - gwave; it < 2 * 32 * nch; it += nwave) { const int m = it % nch, bg = it / nch; s5_item(p, l, bg >> 5, bg & 31, m, 1, lds + wid * S5_WLDS); }
        __syncthreads();
      }
#endif
    }
    xcd_barrier(xb);
    {
      PHASE_VARS
      const int rows = need_ctx ? NTOK : 2 * SEQ;
#pragma unroll 1
      for (int br = 1; br < 3; ++br) {
        const int acol = br == 1 ? C_ZN : C_ZM;
        pg8::Gemm g{P + acol, (const bf16_t*)(ws + WS_WBR) + (size_t)br * 1024 * 512, rows, 1024, 512, NP, 512};
        pg8::StaticOrder S; S.init(rows, 1024, nblk, br == 1 ? blk : (blk + nblk - 8) % nblk); S.skipctx = need_ctx ? 0 : 1;
        pg8::EpiBranch E{br == 1 ? H : (bf16_t*)(ws + WS_K), P + C_GA + br * 1024, NP, 1, nullptr};
        pg8::gemm_phase<pg8::EpiBranch, pg8::StaticOrder, true, true>((PG8_LAS unsigned char*)lds, g, S, E);
        __syncthreads();
      }
      {
        pg8::Gemm g{P + C_UA, (const bf16_t*)(ws + WS_WGLU), rows, 512, 512, NP, 512};
        pg8::StaticOrder S; S.init(rows, 512, nblk, nblk - 1 - blk); S.skipctx = need_ctx ? 0 : 1;
        pg8::EpiGlu E{P, NP, C_UA, C_ZA, p.in[16] + l * 512};
        pg8::gemm_phase<pg8::EpiGlu, pg8::StaticOrder, true, true>((PG8_LAS unsigned char*)lds, g, S, E);
      }
    }
    xcd_barrier(xb);
    {
      PHASE_VARS
      const int rows = need_ctx ? NTOK : 2 * SEQ;
      pg8::Gemm g{P + C_ZA, (const bf16_t*)(ws + WS_WBR), rows, 1024, 512, NP, 512};
      pg8::StaticOrder S; S.init(rows, 1024, nblk, blk); S.skipctx = need_ctx ? 0 : 1;
      pg8::EpiBranch E{H, P + C_GA, NP, 0, (const bf16_t*)(ws + WS_K)};
      pg8::gemm_phase<pg8::EpiBranch, pg8::StaticOrder, true, true>((PG8_LAS unsigned char*)lds, g, S, E);
    }
    xcd_barrier(xb);
    {
      PHASE_VARS
      {
        pg8::Gemm g{H, (const bf16_t*)(ws + WS_WOUT), 2 * SEQ, 1024, 1024, 1024, 1024};
        pg8::StaticOrder S; S.init(2 * SEQ, 1024, nblk, blk); S.skipctx = 1;
        pg8::EpiOutResid E{X, MOD + (size_t)l * 3 * 3072 + 2048, l == 0 ? p.in[0] : nullptr, l == 0 ? p.in[2] : nullptr};
        pg8::gemm_phase<pg8::EpiOutResid, pg8::StaticOrder, true, true>((PG8_LAS unsigned char*)lds, g, S, E);
      }
    }
    if (need_ctx) {
      __syncthreads();
      PHASE_VARS
      const int s = (blk >> 3) & 3;
      pg8::Gemm g{H + s * 256, (const bf16_t*)(ws + WS_WOUT) + s * 256, NTOK, 1024, 256, 1024, 1024};
      pg8::CtxOrder S{blk < 32 ? (blk & 7) : -1};
      pg8::EpiOutPart E{(float*)(ws + WS_XP) + (size_t)s * 512 * 1024, MOD + (size_t)(l * 3 + 2) * 3072 + 2048};
      pg8::gemm_phase<pg8::EpiOutPart, pg8::CtxOrder, true, true>((PG8_LAS unsigned char*)lds, g, S, E);
    }
    xcd_barrier(xb);
    {
      PHASE_VARS
      const float* lg = p.in[26] + l * 1024; const float* lb = p.in[27] + l * 1024;
      const bool last = (l == DEPTH - 1);
#define P7_SKIP(n_) (last && ((n_) % TB) >= SEQ)
      int n = gwave; while (n < NTOK && P7_SKIP(n)) n += nwave;
      f32x4 nv[4];
#pragma unroll
      for (int i = 0; i < 4; ++i) nv[i] = (f32x4){0.f, 0.f, 0.f, 0.f};
      if (n < NTOK) {
#pragma unroll
        for (int i = 0; i < 4; ++i) nv[i] = *(const f32x4*)(X + (size_t)n * 1024 + lane * 4 + 256 * i);
      }
      while (n < NTOK) {
        const int b = n / TB, t = n % TB, vs = (t < SEQ) ? b : 2;
        f32x4 v[4];
#pragma unroll
        for (int i = 0; i < 4; ++i) v[i] = nv[i];
        int nn = n + nwave; while (nn < NTOK && P7_SKIP(nn)) nn += nwave;
        if (nn < NTOK) {
#pragma unroll
          for (int i = 0; i < 4; ++i) nv[i] = *(const f32x4*)(X + (size_t)nn * 1024 + lane * 4 + 256 * i);
        }
        if (t >= SEQ) {
          const size_t cr = (size_t)(b * CTX + (t - SEQ)) * 1024;
          const float* xp0 = (const float*)(ws + WS_XP) + cr;
#pragma unroll
          for (int i = 0; i < 4; ++i) {
            const int c = lane * 4 + 256 * i;
            f32x4 base = v[i];
            if (l == 0) base = *(const f32x4*)(p.in[2] + cr + c) * DN_ALPHA;
            v[i] = base + ((*(const f32x4*)(xp0 + c) + *(const f32x4*)(xp0 + (size_t)512 * 1024 + c)) + (*(const f32x4*)(xp0 + (size_t)2 * 512 * 1024 + c) + *(const f32x4*)(xp0 + (size_t)3 * 512 * 1024 + c)));
          }
        }
        wave_ln(v);
#pragma unroll
        for (int i = 0; i < 4; ++i) { const int c = lane * 4 + 256 * i; v[i] = v[i] * *(const f32x4*)(lg + c) + *(const f32x4*)(lb + c); }
        if (last) {
#pragma unroll
          for (int i = 0; i < 4; ++i) *(f32x4*)(p.out + ((size_t)(b * SEQ + t)) * 1024 + lane * 4 + 256 * i) = v[i];
        } else {
#pragma unroll
          for (int i = 0; i < 4; ++i) *(f32x4*)(X + (size_t)n * 1024 + lane * 4 + 256 * i) = v[i] * DN_ALPHA;
          const float* md = MOD + (size_t)((l + 1) * 3 + vs) * 3072;
          wave_ln(v);
#pragma unroll
          for (int i = 0; i < 4; ++i) {
            const int c = lane * 4 + 256 * i;
            const f32x4 sh = *(const f32x4*)(md + c), sc = *(const f32x4*)(md + 1024 + c);
            const f32x4 h = v[i] * (sc + 1.0f) + sh;
            u32x2 w; w[0] = pk2(h[0], h[1]); w[1] = pk2(h[2], h[3]);
            *(u32x2*)(H + (size_t)n * 1024 + c) = w;
          }
        }
        n = nn;
      }
#undef P7_SKIP
      if (!last) convert_layer_weights(p, l + 1, gtid, gthreads, 1);
    }
    if (l + 1 < DEPTH) xcd_barrier(xb);
  }
}

extern "C" void kernel_launch(void* const* d_in, const int* in_sizes, int n_in, void* d_out, int out_size, void* d_ws, size_t ws_size, hipStream_t stream) {
  static int grid = 0;
  if (grid == 0) {
    int dev = 0, cus = 0, per_cu = 0;
    hipGetDevice(&dev);
    hipDeviceGetAttribute(&cus, hipDeviceAttributeMultiprocessorCount, dev);
    hipFuncSetAttribute((const void*)hybrid_fwd, hipFuncAttributeMaxDynamicSharedMemorySize, LDS_BYTES);
    hipOccupancyMaxActiveBlocksPerMultiprocessor(&per_cu, (const void*)hybrid_fwd, 512, LDS_BYTES);
    if (per_cu < 1) fprintf(stderr, "kernel_launch: occupancy query says %d blocks/CU\n", per_cu);
    (void)hipGetLastError();
    grid = cus > 0 ? cus : 256;
    if (ws_size < WS_END) { fprintf(stderr, "kernel_launch: workspace too small (%zu < %zu)\n", ws_size, (size_t)WS_END); grid = -1; }
  }
  if (grid < 0) return;
  Params p{};
  for (int i = 0; i < 28; ++i) p.in[i] = (const float*)d_in[i];
  p.out = (float*)d_out; p.ws = (unsigned char*)d_ws;
  void* args[] = {&p};
  hipError_t e = hipLaunchCooperativeKernel((const void*)hybrid_fwd, dim3(grid), dim3(512), args, LDS_BYTES, stream);
  if (e != hipSuccess) fprintf(stderr, "cooperative launch failed: %s (grid %d)\n", hipGetErrorString(e), grid);
}
```
